# Optimizing an MI355X kernel written in HIP

```python
import math
import jax, jax.numpy as jnp
from jax import lax
import numpy as np

D_MODEL = 1024
BATCH = 8
SEQ = 2048
DEPTH = 1
DEC_BATCH = 128
DEC_SEQ = 4
PAST_LEN = 16384
PAGE_SIZE = 128

D_MIX = D_MODEL
D_GLA = D_MIX // 2
D_CONV = D_MIX - D_GLA
GLA_HEADS = 4
GLA_DV = D_GLA // GLA_HEADS
GLA_DK = GLA_DV // 2
D_GLA_K = GLA_HEADS * GLA_DK
GATE_RANK = 16
GATE_NORMALIZER = 16.0
GLA_CHUNK = 64
CONV_WIDTH = 3
NORM_EPS = 1e-6

SPLIT_SIZES = [D_GLA_K, D_GLA_K, D_GLA, D_GLA, GATE_RANK, D_CONV, D_CONV, D_CONV, D_CONV]
N_IN = sum(SPLIT_SIZES)
SPLIT_IDX = np.cumsum(SPLIT_SIZES)[:-1].tolist()

kernel_name = "hymba_gla_shortconv_decode_step"


def rmsnorm(x, g):
    xf = x.astype(jnp.float32)
    y = xf * lax.rsqrt(jnp.mean(xf * xf, axis=-1, keepdims=True) + NORM_EPS)
    return (y * g.astype(jnp.float32)).astype(x.dtype)


def gla_chunked(q, k, v, gk, S0):
    B, L, H, DK = q.shape
    DV = v.shape[-1]
    C = math.gcd(L, GLA_CHUNK)
    N = L // C

    def to_chunks(t):
        return t.astype(jnp.float32).reshape(B, N, C, H, t.shape[-1]).transpose(1, 0, 3, 2, 4)

    mask = jnp.tril(jnp.ones((C, C), dtype=bool))

    def step(S, inp):
        qc, kc, vc, gc = inp
        b = jnp.cumsum(gc, axis=2)
        inter = jnp.einsum('bhtk,bhkv->bhtv', qc * jnp.exp(b), S)
        rel = b[:, :, :, None, :] - b[:, :, None, :, :]
        decay = jnp.exp(jnp.where(mask[:, :, None], rel, -jnp.inf))
        A = jnp.einsum('bhtk,bhtsk,bhsk->bhts', qc, decay, kc)
        intra = jnp.einsum('bhts,bhsv->bhtv', A, vc)
        b_last = b[:, :, -1:, :]
        S_new = jnp.exp(b_last[:, :, 0, :])[..., None] * S + jnp.einsum(
            'bhsk,bhsv->bhkv', kc * jnp.exp(b_last - b), vc)
        return S_new, inter + intra

    S_fin, o = lax.scan(step, S0.astype(jnp.float32),
                        (to_chunks(q), to_chunks(k), to_chunks(v), to_chunks(gk)))
    o = o.transpose(1, 0, 3, 2, 4).reshape(B, L, H, DV)
    return o, S_fin


def mixer_layer(x, S0, conv0, norm_gain, w_in, w_gk_up, b_gk, gla_norm_gain, conv_w, w_out):
    B, L, _ = x.shape
    h = rmsnorm(x, norm_gain)
    proj = jnp.einsum('bld,dn->bln', h, w_in)
    q, k, v, g_gla, gk_lr, u, b_gate, c_gate, g_conv = jnp.split(proj, SPLIT_IDX, axis=-1)

    q = q.reshape(B, L, GLA_HEADS, GLA_DK) * (GLA_DK ** -0.5)
    k = k.reshape(B, L, GLA_HEADS, GLA_DK)
    v = v.reshape(B, L, GLA_HEADS, GLA_DV)
    gk = jax.nn.log_sigmoid(
        (jnp.einsum('blr,rk->blk', gk_lr, w_gk_up) + b_gk).astype(jnp.float32)) / GATE_NORMALIZER
    gk = gk.reshape(B, L, GLA_HEADS, GLA_DK)
    o, S_new = gla_chunked(q, k, v, gk, S0)
    o = rmsnorm(o, gla_norm_gain).reshape(B, L, D_GLA).astype(x.dtype)
    o = o * jax.nn.silu(g_gla)

    hc = c_gate * u
    hp = jnp.concatenate([conv0.astype(hc.dtype), hc], axis=1)
    yc = sum(conv_w[j] * hp[:, j:j + L] for j in range(CONV_WIDTH))
    conv_new = hp[:, -(CONV_WIDTH - 1):]
    yc = b_gate * yc * jax.nn.silu(g_conv)

    mix = jnp.concatenate([o, yc], axis=-1)
    out = x + jnp.einsum('blm,md->bld', mix, w_out)
    return out, S_new.astype(S0.dtype), conv_new.astype(conv0.dtype)


def setup_inputs(seed: int = 0) -> dict:
    key = jax.random.key(seed)
    ks = jax.random.split(key, 12)
    f32 = jnp.float32
    return {
        "x_prompt": jax.random.normal(ks[0], (BATCH, SEQ, D_MODEL), f32),
        "x_sample": jax.random.normal(ks[1], (DEC_BATCH, DEC_SEQ, D_MODEL), f32),
        "state_gla": 0.3 * jax.random.normal(ks[2], (DEPTH, DEC_BATCH, GLA_HEADS, GLA_DK, GLA_DV), f32),
        "state_conv": jax.random.normal(ks[3], (DEPTH, DEC_BATCH, CONV_WIDTH - 1, D_CONV), f32),
        "norm_gain": 1.0 + 0.01 * jax.random.normal(ks[4], (DEPTH, D_MODEL), f32),
        "w_in": jax.random.normal(ks[5], (DEPTH, D_MODEL, N_IN), f32) * D_MODEL ** -0.5,
        "w_gk_up": jax.random.normal(ks[6], (DEPTH, GATE_RANK, D_GLA_K), f32) * GATE_RANK ** -0.5,
        "b_gk": 0.1 * jax.random.normal(ks[7], (DEPTH, D_GLA_K), f32),
        "gla_norm_gain": 1.0 + 0.01 * jax.random.normal(ks[8], (DEPTH, GLA_DV), f32),
        "conv_w": jax.random.normal(ks[9], (DEPTH, CONV_WIDTH, D_CONV), f32) * CONV_WIDTH ** -0.5,
        "w_out": jax.random.normal(ks[10], (DEPTH, D_MIX, D_MODEL), f32) * D_MIX ** -0.5,
        "final_norm_gain": 1.0 + 0.01 * jax.random.normal(ks[11], (D_MODEL,), f32),
    }


def reference(x_prompt, x_sample, state_gla, state_conv, norm_gain, w_in, w_gk_up, b_gk,
              gla_norm_gain, conv_w, w_out, final_norm_gain):
    hp, hs = x_prompt, x_sample
    Bp = x_prompt.shape[0]
    gla_p, conv_p, gla_s, conv_s = [], [], [], []
    for l in range(DEPTH):
        params = (norm_gain[l], w_in[l], w_gk_up[l], b_gk[l], gla_norm_gain[l], conv_w[l], w_out[l])
        S0p = jnp.zeros((Bp, GLA_HEADS, GLA_DK, GLA_DV), state_gla.dtype)
        c0p = jnp.zeros((Bp, CONV_WIDTH - 1, D_CONV), state_conv.dtype)
        hp, Sp, cp = mixer_layer(hp, S0p, c0p, *params)
        hs, Ss, cs = mixer_layer(hs, state_gla[l], state_conv[l], *params)
        gla_p.append(Sp)
        conv_p.append(cp)
        gla_s.append(Ss)
        conv_s.append(cs)
    y_prompt = rmsnorm(hp, final_norm_gain)
    y_sample = rmsnorm(hs, final_norm_gain)
    return (y_prompt, y_sample, jnp.stack(gla_p), jnp.stack(conv_p), jnp.stack(gla_s), jnp.stack(conv_s))
```

```cpp
#include <hip/hip_runtime.h>
#include <hip/hip_cooperative_groups.h>
#include <cstdio>
#include <cstdint>
namespace cg = cooperative_groups;
namespace pg8 {
#define PG8_LAS __attribute__((address_space(3)))
typedef unsigned short bf16_t;
typedef short bf16x8 __attribute__((ext_vector_type(8)));
typedef float f32x4 __attribute__((ext_vector_type(4)));
typedef unsigned u32x4 __attribute__((ext_vector_type(4)));
constexpr int BM = 256, BK = 64, HALF = 128, HTB = HALF * BK * 2  , STAGE_BYTES = 8 * HTB, NXCD = 8, WGM = 8;

__host__ __device__ __forceinline__ int lds_byte(int r, int c) { const int st = (r >> 4) * 2 + (c >> 5), rr = r & 15, cc = c & 31, ob = rr * 64 + cc * 2; return st * 1024 + (ob ^ (((ob >> 9) & 1) << 5)); }
__host__ __device__ __forceinline__ void stage_rc(int b, int& R, int& C) { const int st = b / 1024, sb = b % 1024, swz = sb ^ (((sb >> 9) & 1) << 5); R = (st >> 1) * 16 + swz / 64; C = (st & 1) * 32 + (swz % 64) / 2; }
__host__ __device__ __forceinline__ int perm32(int rho) { const int n = rho >> 4, i = rho & 15; return 8 * (i >> 2) + 4 * n + (i & 3); }

struct Unit { int pm, pn; };
struct Gemm { const bf16_t* A; const bf16_t* Bt; int M, N, K; };

struct StaticOrder {
    int nM, nN, nwg, G, c;
    __host__ __device__ void init(int M, int N, int G_, int c_) { nM = M / BM; nN = N / BM; nwg = nM * nN; G = G_; c = c_; }
    __host__ __device__ bool next(int i, Unit& u) const {
        const long L = (long)i * G + c; if (L >= nwg) return false;
        int wgid = (int)L; { const int q = nwg / NXCD, r = nwg % NXCD, xcd = wgid % NXCD, off = wgid / NXCD; wgid = (xcd < r ? xcd * (q + 1) : r * (q + 1) + (xcd - r) * q) + off; }
        const int nig = WGM * nN, gid = wgid / nig, fm = gid * WGM, gsz = (nM - fm) < WGM ? (nM - fm) : WGM;
        u.pm = fm + ((wgid % nig) % gsz); u.pn = (wgid % nig) / gsz; return true;
    }
    __device__ __forceinline__ void a_ready(const Unit&) const {}
    __device__ __forceinline__ void done(const Unit&) const {}
};

__device__ __forceinline__ unsigned cvt_pk_bf16(float lo, float hi) { unsigned r; asm volatile("v_cvt_pk_bf16_f32 %0, %1, %2" : "=v"(r) : "v"(lo), "v"(hi)); return r; }
template <int ACT  > struct EpiBf16 {
    static constexpr bool PERM = true, AFTER_DRAIN = false; static_assert(ACT == 0 || ACT == 1, "EpiBf16: ACT is 0 (none) or 1 (gelu_pk)");
    bf16_t* O; int ldc; const float* bias; int split_cols; size_t split_stride; float scale0;
    __device__ __forceinline__ void operator()(const f32x4 (&acc)[2][2][4][2], const Unit& u, int wr, int wc, int fr, int fq) const {
        const int row0 = u.pm * BM + wr * 64 + fr; int colt = u.pn * BM; bf16_t* base = O;
        float sc = 1.f; if (split_cols) { const int t = colt / split_cols; base += (size_t)t * split_stride; colt -= t * split_cols; if (t == 0) sc = scale0; }
        const int col0 = colt + wc * 32 + 8 * fq, bcol0 = u.pn * BM + wc * 32 + 8 * fq;
        f32x4 bv[2][2];
#pragma unroll
        for (int bj = 0; bj < 2; ++bj)
#pragma unroll
            for (int n = 0; n < 2; ++n) bv[bj][n] = bias ? *(const f32x4*)(bias + bcol0 + bj * HALF + 4 * n) : (f32x4){0.f, 0.f, 0.f, 0.f};
#pragma unroll
        for (int ai = 0; ai < 2; ++ai)
#pragma unroll
            for (int m = 0; m < 4; ++m) { bf16_t* rowp = base + (size_t)(row0 + ai * HALF + m * 16) * ldc + col0;
#pragma unroll
                for (int bj = 0; bj < 2; ++bj) { f32x4 v0 = acc[ai][bj][m][0] + bv[bj][0], v1 = acc[ai][bj][m][1] + bv[bj][1];
                    v0 = v0 * sc; v1 = v1 * sc; u32x4 w; w.x = cvt_pk_bf16(v0[0], v0[1]); w.y = cvt_pk_bf16(v0[2], v0[3]); w.z = cvt_pk_bf16(v1[0], v1[1]); w.w = cvt_pk_bf16(v1[2], v1[3]);
                    *(u32x4*)(rowp + bj * HALF) = w; } }
    }
};
struct EpiResF32 {
    static constexpr bool PERM = false, AFTER_DRAIN = false;
    const float* xp; const float* xs; float* out; float* rss;
    __device__ __forceinline__ void operator()(const f32x4 (&acc)[2][2][4][2], const Unit& u, int wr, int wc, int fr, int fq) const {
        const int row0 = u.pm * BM + wr * 64 + fr, col0 = u.pn * BM + wc * 32 + 4 * fq;
        const float* xb = (u.pm < 64) ? xp : xs; const int roff = (u.pm < 64) ? 0 : 16384;
#pragma unroll
        for (int ai = 0; ai < 2; ++ai)
#pragma unroll
            for (int m = 0; m < 4; ++m) { const int row = row0 + ai * HALF + m * 16; const float* xr = xb + (size_t)(row - roff) * 1024 + col0; float* orow = out + (size_t)row * 1024 + col0; float ss = 0.f;
#pragma unroll
                for (int bj = 0; bj < 2; ++bj)
#pragma unroll
                    for (int n = 0; n < 2; ++n) { const f32x4 xv = *(const f32x4*)(xr + bj * HALF + n * 16); const f32x4 o = acc[ai][bj][m][n] + xv;
                        ss += (o[0] * o[0] + o[1] * o[1]) + (o[2] * o[2] + o[3] * o[3]); *(f32x4*)(orow + bj * HALF + n * 16) = o; }
                ss += __shfl_xor(ss, 16); ss += __shfl_xor(ss, 32);
                if (fq == 0) rss[(size_t)row * 16 + u.pn * 4 + wc] = ss; }
    }
};
template <class Epi, class Sched, bool ALIGN_EPI = false, bool SP2 = false>
__device__ __forceinline__ void gemm_phase(PG8_LAS unsigned char* lds, const Gemm g, const Sched& S, const Epi& E) {
    const int tid = threadIdx.x, wid = __builtin_amdgcn_readfirstlane(tid >> 6), lane = tid & 63, wr = wid >> 2, wc = wid & 3, fr = lane & 15, fq = lane >> 4;
    const int K = g.K, nt = K / BK;
    unsigned voffA[2], voffB[2];
#pragma unroll
    for (int i = 0; i < 2; ++i) { int R, C; stage_rc(tid * 16 + i * 8192, R, C); const int Rb = Epi::PERM ? ((R & ~31) + perm32(R & 31)) : R;
        voffA[i] = (unsigned)(R * K + C) * 2u; voffB[i] = (unsigned)(Rb * K + C) * 2u; }
    const size_t kstep = (size_t)(BK * 2);
    const size_t hstep = (size_t)HALF * K * 2;
    const size_t tstep = 2 * hstep;
    const unsigned ldsw = (unsigned)wid * 1024u;
    const int aoff = lds_byte(wr * 64 + fr, fq * 8), boff = lds_byte(wc * 32 + fr, fq * 8);
#define PG8_SA(b, h) (((b) * 2 + (h)) * HTB)
#define PG8_SB(b, h) ((4 + (b) * 2 + (h)) * HTB)
#define PG8_STAGE(bufoff, gbase, voff) do { _Pragma("unroll") for (int _i = 0; _i < 2; ++_i) \
        __builtin_amdgcn_global_load_lds((const unsigned*)((const char*)(gbase) + (voff)[_i]), (PG8_LAS unsigned*)(lds + (bufoff) + ldsw + _i * 8192), 16, 0, 0); } while (0)
#define PG8_LDA(dst, b, h) do { _Pragma("unroll") for (int m = 0; m < 4; ++m) _Pragma("unroll") for (int k = 0; k < 2; ++k) dst[m][k] = *(const PG8_LAS bf16x8*)(lds + PG8_SA(b, h) + aoff + m * 2048 + k * 1024); } while (0)
#define PG8_LDB(dst, b, h) do { _Pragma("unroll") for (int n = 0; n < 2; ++n) _Pragma("unroll") for (int k = 0; k < 2; ++k) dst[n][k] = *(const PG8_LAS bf16x8*)(lds + PG8_SB(b, h) + boff + n * 2048 + k * 1024); } while (0)
#define PG8_MMA(ai, bj, At, Bt) do { __builtin_amdgcn_s_setprio(1); _Pragma("unroll") for (int m = 0; m < 4; ++m) _Pragma("unroll") for (int n = 0; n < 2; ++n) _Pragma("unroll") for (int k = 0; k < 2; ++k) \
        acc[ai][bj][m][n] = __builtin_amdgcn_mfma_f32_16x16x32_bf16(Bt[n][k], At[m][k], acc[ai][bj][m][n], 0, 0, 0); __builtin_amdgcn_s_setprio(0); } while (0)
#define PG8_WAIT_V(n) asm volatile("s_waitcnt vmcnt(" #n ")" ::: "memory")
#define PG8_WAIT_L(n) asm volatile("s_waitcnt lgkmcnt(" #n ")" ::: "memory")
#define PG8_BAR __builtin_amdgcn_s_barrier()
#define PG8_SCHED __builtin_amdgcn_sched_barrier(0)
    Unit cur, nxt; int ui = 0;
    if (!S.next(0, cur)) return;
    f32x4 acc[2][2][4][2];
#pragma unroll
    for (int a = 0; a < 2; ++a)
#pragma unroll
        for (int b = 0; b < 2; ++b)
#pragma unroll
            for (int m = 0; m < 4; ++m)
#pragma unroll
                for (int n = 0; n < 2; ++n) acc[a][b][m][n] = (f32x4){0.f, 0.f, 0.f, 0.f};
    bf16x8 At[4][2], B0[2][2], B1[2][2];
    const char* cA = (const char*)g.A + (size_t)cur.pm * tstep; const char* cB = (const char*)g.Bt + (size_t)cur.pn * tstep;
    S.a_ready(cur);
    if constexpr (SP2) {
        PG8_STAGE(PG8_SB(0, 0), cB, voffB); PG8_STAGE(PG8_SB(0, 1), cB + hstep, voffB); PG8_STAGE(PG8_SA(0, 0), cA, voffA); PG8_STAGE(PG8_SA(0, 1), cA + hstep, voffA);
        if (wr == 1) PG8_BAR;
        PG8_WAIT_V(2); PG8_BAR;
        PG8_STAGE(PG8_SB(1, 0), cB + kstep, voffB); PG8_STAGE(PG8_SA(1, 0), cA + kstep, voffA); PG8_STAGE(PG8_SB(1, 1), cB + hstep + kstep, voffB);
        PG8_WAIT_V(6); PG8_BAR;
    } else {
        PG8_STAGE(PG8_SB(0, 0), cB, voffB); PG8_STAGE(PG8_SA(0, 0), cA, voffA); PG8_STAGE(PG8_SB(0, 1), cB + hstep, voffB); PG8_STAGE(PG8_SA(0, 1), cA + hstep, voffA);
        if (wr == 1) PG8_BAR;
        PG8_WAIT_V(4); PG8_BAR;
        PG8_STAGE(PG8_SB(1, 0), cB + kstep, voffB); PG8_STAGE(PG8_SA(1, 0), cA + kstep, voffA); PG8_STAGE(PG8_SB(1, 1), cB + hstep + kstep, voffB);
        PG8_WAIT_V(6); PG8_BAR;
    }
    for (;;) {
        const bool has_next = S.next(ui + 1, nxt);
        const char* nA = has_next ? (const char*)g.A + (size_t)nxt.pm * tstep : cA; const char* nB = has_next ? (const char*)g.Bt + (size_t)nxt.pn * tstep : cB;
        for (int t = 0; t < nt; t += 2) {
            const bool last = (t == nt - 2);
            const char* a1 = cA + (size_t)(t + 1) * kstep;
            const char* a2 = last ? nA : cA + (size_t)(t + 2) * kstep; const char* b2 = last ? nB : cB + (size_t)(t + 2) * kstep;
            const char* a3 = a2 + kstep; const char* b3 = b2 + kstep;
            if (last && has_next) S.a_ready(nxt);
            if constexpr (SP2) {
            PG8_LDB(B0, 0, 0); PG8_LDB(B1, 0, 1); PG8_SCHED; PG8_LDA(At, 0, 0); PG8_STAGE(PG8_SA(1, 1), a1 + hstep, voffA);
            PG8_WAIT_V(8); PG8_WAIT_L(0); PG8_BAR; PG8_MMA(0, 0, At, B0); PG8_MMA(0, 1, At, B1); PG8_BAR; PG8_SCHED;
            PG8_LDA(At, 0, 1); PG8_STAGE(PG8_SB(0, 0), b2, voffB); PG8_STAGE(PG8_SB(0, 1), b2 + hstep, voffB); PG8_STAGE(PG8_SA(0, 0), a2, voffA);
            PG8_WAIT_V(8); PG8_WAIT_L(0); PG8_BAR; PG8_MMA(1, 0, At, B0); PG8_MMA(1, 1, At, B1); PG8_BAR; PG8_SCHED;
            PG8_LDB(B0, 1, 0); PG8_LDB(B1, 1, 1); PG8_SCHED; PG8_LDA(At, 1, 0); PG8_STAGE(PG8_SA(0, 1), a2 + hstep, voffA);
            PG8_WAIT_V(8); PG8_WAIT_L(0); PG8_BAR; PG8_MMA(0, 0, At, B0); PG8_MMA(0, 1, At, B1); PG8_BAR; PG8_SCHED;
            PG8_LDA(At, 1, 1); PG8_STAGE(PG8_SB(1, 0), b3, voffB); PG8_STAGE(PG8_SB(1, 1), b3 + hstep, voffB); PG8_STAGE(PG8_SA(1, 0), a3, voffA);
            PG8_WAIT_V(8); PG8_WAIT_L(0); PG8_BAR; PG8_MMA(1, 0, At, B0); PG8_MMA(1, 1, At, B1); PG8_BAR; PG8_SCHED;
            } else {
            PG8_LDB(B0, 0, 0); PG8_SCHED; PG8_LDA(At, 0, 0); PG8_STAGE(PG8_SA(1, 1), a1 + hstep, voffA);
            PG8_WAIT_L(8); PG8_BAR; PG8_WAIT_L(0); PG8_MMA(0, 0, At, B0); PG8_BAR; PG8_SCHED;
            PG8_LDB(B1, 0, 1); PG8_STAGE(PG8_SB(0, 0), b2, voffB);
            PG8_BAR; PG8_WAIT_L(0); PG8_MMA(0, 1, At, B1); PG8_BAR;
            PG8_LDA(At, 0, 1); PG8_STAGE(PG8_SA(0, 0), a2, voffA);
            PG8_BAR; PG8_WAIT_L(0); PG8_MMA(1, 0, At, B0); PG8_BAR; PG8_SCHED;
            PG8_STAGE(PG8_SB(0, 1), b2 + hstep, voffB);
            PG8_WAIT_V(6); PG8_BAR; PG8_MMA(1, 1, At, B1); PG8_BAR;
            PG8_LDB(B0, 1, 0); PG8_SCHED; PG8_LDA(At, 1, 0); PG8_STAGE(PG8_SA(0, 1), a2 + hstep, voffA);
            PG8_WAIT_L(8); PG8_BAR; PG8_WAIT_L(0); PG8_MMA(0, 0, At, B0); PG8_BAR; PG8_SCHED;
            PG8_LDB(B1, 1, 1); PG8_STAGE(PG8_SB(1, 0), b3, voffB);
            PG8_BAR; PG8_WAIT_L(0); PG8_MMA(0, 1, At, B1); PG8_BAR;
            PG8_LDA(At, 1, 1); PG8_STAGE(PG8_SA(1, 0), a3, voffA);
            PG8_BAR; PG8_WAIT_L(0); PG8_MMA(1, 0, At, B0); PG8_BAR; PG8_SCHED;
            PG8_STAGE(PG8_SB(1, 1), b3 + hstep, voffB);
            PG8_WAIT_V(6); PG8_BAR; PG8_MMA(1, 1, At, B1); PG8_BAR;
            }
        }
        if constexpr (ALIGN_EPI) { if (wr == 0) PG8_BAR; }
        if constexpr (!Epi::AFTER_DRAIN) { E(acc, cur, wr, wc, fr, fq); S.done(cur); }
        if (!has_next) break;
#pragma unroll
        for (int a = 0; a < 2; ++a)
#pragma unroll
            for (int b = 0; b < 2; ++b)
#pragma unroll
                for (int m = 0; m < 4; ++m)
#pragma unroll
                    for (int n = 0; n < 2; ++n) acc[a][b][m][n] = (f32x4){0.f, 0.f, 0.f, 0.f};
        cur = nxt; cA = nA; cB = nB; ++ui;
        if constexpr (ALIGN_EPI) { if (wr == 1) PG8_BAR; }
    }
    PG8_WAIT_V(0);
    if constexpr (!ALIGN_EPI) { if (wr == 0) PG8_BAR; }
    PG8_BAR;
    if constexpr (Epi::AFTER_DRAIN) { E.fused(acc, cur, wr, wc, fr, fq, lds, wid, lane); S.done(cur); }
#undef PG8_SA
#undef PG8_SB
#undef PG8_STAGE
#undef PG8_LDA
#undef PG8_LDB
#undef PG8_MMA
#undef PG8_WAIT_V
#undef PG8_WAIT_L
#undef PG8_BAR
#undef PG8_SCHED
}
}

#ifndef PG8_SP2
#define PG8_SP2 true
#endif
#ifndef PG8_ALIGN
#define PG8_ALIGN true
#endif

typedef unsigned short bf16;
typedef short bf16x8 __attribute__((ext_vector_type(8)));
typedef float f32x4 __attribute__((ext_vector_type(4)));
typedef float f32x2 __attribute__((ext_vector_type(2)));
typedef unsigned u32x4 __attribute__((ext_vector_type(4)));
typedef unsigned u32x2 __attribute__((ext_vector_type(2)));
#define LAS __attribute__((address_space(3)))

constexpr int NWAVES = 8, NTHR = 512;
constexpr int DM = 1024, NPROMPT = 16384, MROWS = 16896, NIN = 3600, NINP = 3840;
constexpr int C_Q = 0, C_K = 256, C_V = 512, C_G = 1024, C_LR = 1536, C_U = 1552, C_B = 2064, C_C = 2576, C_GC = 3088;
constexpr float EPS = 1e-6f;
constexpr int NCHUNK_UNITS = 1024;
constexpr int NSAMP_UNITS = 512;
constexpr size_t O_Y = 0, O_GLA_P = 17301504, O_CONV_P = 17563648, O_GLA_S = 17571840, O_CONV_S = 21766144;
constexpr size_t MiB = 1u << 20;
constexpr size_t WS_WTIN = 2 * MiB;
constexpr size_t WS_QE = 2 * MiB;
constexpr size_t WS_WTOUT = 10 * MiB;
constexpr size_t WS_XN = 12 * MiB;
constexpr size_t WS_OI = 12 * MiB;
constexpr size_t WS_D = 44 * MiB;
constexpr size_t WS_RSS = 45 * MiB;
constexpr size_t WS_P = 47 * MiB;
constexpr size_t WS_MIX = 171 * MiB;
constexpr size_t WS_KV = 204 * MiB;
constexpr size_t WS_SN = 236 * MiB;
constexpr size_t WS_END = 252 * MiB;
constexpr int LDS_BYTES = 147456;

__device__ __forceinline__ float bf2f(unsigned b) { return __uint_as_float(b << 16); }
__device__ __forceinline__ unsigned f2bf(float f) { unsigned u = __float_as_uint(f); return (u + 0x7fffu + ((u >> 16) & 1u)) >> 16; }
__device__ __forceinline__ unsigned pk2(float lo, float hi) { return pg8::cvt_pk_bf16(lo, hi); }
__device__ __forceinline__ float blo(unsigned w) { return __uint_as_float(w << 16); }
__device__ __forceinline__ float bhi(unsigned w) { return __uint_as_float(w & 0xffff0000u); }
__device__ __forceinline__ float wave_sum(float v) {
#pragma unroll
    for (int o = 1; o < 64; o <<= 1) v += __shfl_xor(v, o);
    return v;
}
__device__ __forceinline__ float silu(float x) { return x / (1.f + __expf(-x)); }
__device__ __forceinline__ float logsigmoid(float x) { return fminf(x, 0.f) - log1pf(expf(-fabsf(x))); }
#define LDS_WAIT() asm volatile("s_waitcnt lgkmcnt(0)" ::: "memory")

struct Args { const float* in[12]; float* out; unsigned char* ws; };

__device__ __forceinline__ f32x4 tile_mma(const bf16* A, int lda, const bf16* Bt, int ldb, int m0, int n0, int K, int lane) {
    f32x4 acc = {0.f, 0.f, 0.f, 0.f};
    const int fr = lane & 15, fq = lane >> 4;
#pragma unroll
    for (int k0 = 0; k0 < 64; k0 += 32) {
        if (k0 < K) {
            const bf16x8 a = *(const bf16x8*)(A + (m0 + fr) * lda + k0 + fq * 8);
            const bf16x8 b = *(const bf16x8*)(Bt + (n0 + fr) * ldb + k0 + fq * 8);
            acc = __builtin_amdgcn_mfma_f32_16x16x32_bf16(a, b, acc, 0, 0, 0);
        }
    }
    return acc;
}

__device__ __forceinline__ void p0_transpose_item(const float* W, const float* gain, int N, int nblk, bf16* WT, float* scr, int item, int lane) {
    const int kb = item / nblk, nb = item % nblk, k0 = 64 * kb, n0 = 32 * nb;
    const int nn = n0 + (lane & 31);
#pragma unroll 8
    for (int i = 0; i < 32; ++i) { const int kk = 2 * i + (lane >> 5); float v = 0.f; if (nn < N) v = W[(size_t)(k0 + kk) * N + nn]; if (gain) v *= gain[k0 + kk]; scr[kk * 33 + (lane & 31)] = v; }
    LDS_WAIT(); asm volatile("" ::: "memory");
    const int c = lane & 7;
#pragma unroll
    for (int j = 0; j < 4; ++j) { const int n = (lane >> 3) + 8 * j; const float* s = scr + (8 * c) * 33 + n;
        u32x4 o; o.x = pk2(s[0 * 33], s[1 * 33]); o.y = pk2(s[2 * 33], s[3 * 33]); o.z = pk2(s[4 * 33], s[5 * 33]); o.w = pk2(s[6 * 33], s[7 * 33]);
        *(u32x4*)(WT + (size_t)(n0 + n) * 1024 + k0 + 8 * c) = o; }
    LDS_WAIT(); asm volatile("" ::: "memory");
}
__device__ __forceinline__ void rms_row_to_bf16(const float* xrow, bf16* orow, int lane) {
    const f32x4* xr = (const f32x4*)xrow + lane;
    f32x4 v[4]; float s = 0.f;
#pragma unroll
    for (int j = 0; j < 4; ++j) { v[j] = xr[64 * j]; s += (v[j].x * v[j].x + v[j].y * v[j].y) + (v[j].z * v[j].z + v[j].w * v[j].w); }
    const float rs = 1.f / sqrtf(wave_sum(s) * (1.f / 1024.f) + EPS);
    u32x2* o8 = (u32x2*)orow + lane;
#pragma unroll
    for (int j = 0; j < 4; ++j) { u32x2 o; o.x = pk2(v[j].x * rs, v[j].y * rs); o.y = pk2(v[j].z * rs, v[j].w * rs); o8[64 * j] = o; }
}

constexpr int L_G = 0, L_SEGT = 17408, L_BL = 19456, L_QE = 19712, L_KD = 28928, L_KET = 38144, L_AS = 47360, L_VT = 56576;
__device__ __forceinline__ void p2a_unit(unsigned char* lds, int unit, const bf16* P, const float* wup, const float* bgk, bf16* QEg, float* OIg, float* KVg, float* Dg, int tid, int w, int lane) {
    float* G = (float*)(lds + L_G); float* SEGT = (float*)(lds + L_SEGT); float* BL = (float*)(lds + L_BL);
    bf16* QE_s = (bf16*)(lds + L_QE); bf16* KD_s = (bf16*)(lds + L_KD); bf16* KET_s = (bf16*)(lds + L_KET); bf16* A_s = (bf16*)(lds + L_AS); bf16* VT_s = (bf16*)(lds + L_VT);
    const int bh = unit >> 5, n = unit & 31, b = bh >> 2, h = bh & 3;
    const int r0 = b * 2048 + n * 64;
    const int t = tid >> 3, kg = tid & 7;
    const bf16* prow = P + (size_t)(r0 + t) * NINP;
    const u32x4 lr0 = *(const u32x4*)(prow + C_LR), lr1 = *(const u32x4*)(prow + C_LR + 8);
    const u32x4 qv = *(const u32x4*)(prow + C_Q + h * 64 + kg * 8);
    const u32x4 kv = *(const u32x4*)(prow + C_K + h * 64 + kg * 8);
    const u32x4 v0 = *(const u32x4*)(prow + C_V + h * 128 + kg * 16), v1 = *(const u32x4*)(prow + C_V + h * 128 + kg * 16 + 8);
    {
        float lr[16];
#pragma unroll
        for (int i = 0; i < 4; ++i) { lr[2 * i] = blo(lr0[i]); lr[2 * i + 1] = bhi(lr0[i]); lr[8 + 2 * i] = blo(lr1[i]); lr[8 + 2 * i + 1] = bhi(lr1[i]); }
        const float* bp = bgk + h * 64 + kg * 8;
        f32x4 x0 = *(const f32x4*)bp, x1 = *(const f32x4*)(bp + 4);
#pragma unroll
        for (int r = 0; r < 16; ++r) { const float* wr = wup + r * 256 + h * 64 + kg * 8; const f32x4 w0 = *(const f32x4*)wr, w1 = *(const f32x4*)(wr + 4); x0 += lr[r] * w0; x1 += lr[r] * w1; }
        f32x4 g0, g1;
#pragma unroll
        for (int j = 0; j < 4; ++j) { g0[j] = logsigmoid(x0[j]) * 0.0625f; g1[j] = logsigmoid(x1[j]) * 0.0625f; }
        *(f32x4*)(G + t * 68 + kg * 8) = g0; *(f32x4*)(G + t * 68 + kg * 8 + 4) = g1;
    }
    __syncthreads();
    {
        const int k = tid & 63, seg = tid >> 6; float run = 0.f;
#pragma unroll
        for (int i = 0; i < 8; ++i) { run += G[(seg * 8 + i) * 68 + k]; G[(seg * 8 + i) * 68 + k] = run; }
        SEGT[seg * 64 + k] = run;
    }
    __syncthreads();
    {
        const int k = tid & 63, seg = tid >> 6; float off = 0.f, tot = 0.f;
#pragma unroll
        for (int s = 0; s < 8; ++s) { const float v = SEGT[s * 64 + k]; tot += v; if (s < seg) off += v; }
#pragma unroll
        for (int i = 0; i < 8; ++i) G[(seg * 8 + i) * 68 + k] += off;
        if (seg == 0) BL[k] = tot;
    }
    __syncthreads();
    {
        const f32x4 b0 = *(const f32x4*)(G + t * 68 + kg * 8), b1 = *(const f32x4*)(G + t * 68 + kg * 8 + 4);
        const f32x4 l0 = *(const f32x4*)(BL + kg * 8), l1 = *(const f32x4*)(BL + kg * 8 + 4);
        float bb[8], bl[8], q[8], k[8], qe[8], kd[8], ke[8];
#pragma unroll
        for (int j = 0; j < 4; ++j) { bb[j] = b0[j]; bb[4 + j] = b1[j]; bl[j] = l0[j]; bl[4 + j] = l1[j]; q[2 * j] = blo(qv[j]); q[2 * j + 1] = bhi(qv[j]); k[2 * j] = blo(kv[j]); k[2 * j + 1] = bhi(kv[j]); }
#pragma unroll
        for (int j = 0; j < 8; ++j) { qe[j] = q[j] * __expf(bb[j]) * 0.125f; kd[j] = k[j] * __expf(-bb[j]); ke[j] = k[j] * __expf(bl[j] - bb[j]); }
        u32x4 qw, kw;
#pragma unroll
        for (int j = 0; j < 4; ++j) { qw[j] = pk2(qe[2 * j], qe[2 * j + 1]); kw[j] = pk2(kd[2 * j], kd[2 * j + 1]); }
        *(u32x4*)(QE_s + t * 72 + kg * 8) = qw; *(u32x4*)(KD_s + t * 72 + kg * 8) = kw;
        *(u32x4*)(QEg + (size_t)unit * 4096 + t * 64 + kg * 8) = qw;
#pragma unroll
        for (int j = 0; j < 8; ++j) KET_s[(kg * 8 + j) * 72 + t] = (bf16)f2bf(ke[j]);
#pragma unroll
        for (int j = 0; j < 4; ++j) { VT_s[(kg * 16 + 2 * j) * 72 + t] = (bf16)(v0[j] & 0xffffu); VT_s[(kg * 16 + 2 * j + 1) * 72 + t] = (bf16)(v0[j] >> 16);
            VT_s[(kg * 16 + 8 + 2 * j) * 72 + t] = (bf16)(v1[j] & 0xffffu); VT_s[(kg * 16 + 8 + 2 * j + 1) * 72 + t] = (bf16)(v1[j] >> 16); }
        if (tid < 64) Dg[unit * 64 + tid] = __expf(BL[tid]);
    }
    __syncthreads();
    const int fr = lane & 15, fq = lane >> 4;
    {
#pragma unroll
        for (int i = 0; i < 2; ++i) { const int idx = w * 2 + i, mt = idx >> 2, nt = idx & 3;
            f32x4 acc = {0.f, 0.f, 0.f, 0.f};
            if (nt <= mt) acc = tile_mma(QE_s, 72, KD_s, 72, mt * 16, nt * 16, 64, lane);
#pragma unroll
            for (int j = 0; j < 4; ++j) { const int tt = mt * 16 + fq * 4 + j, s = nt * 16 + fr; A_s[tt * 72 + s] = (bf16)f2bf(s <= tt ? acc[j] : 0.f); } }
    }
    __syncthreads();
    {
        const int mt = w >> 1;
#pragma unroll
        for (int qd = 0; qd < 4; ++qd) { const int nt = (w & 1) * 4 + qd;
            const f32x4 a1 = tile_mma(A_s, 72, VT_s, 72, mt * 16, nt * 16, 64, lane);
            const f32x4 a2 = tile_mma(KET_s, 72, VT_s, 72, mt * 16, nt * 16, 64, lane);
#pragma unroll
            for (int j = 0; j < 4; ++j) { const size_t o = (size_t)unit * 8192 + (mt * 16 + fq * 4 + j) * 128 + nt * 16 + fr; OIg[o] = a1[j]; KVg[o] = a2[j]; } }
    }
    __syncthreads();
}

constexpr int LS_A = 0, LS_Q = 1024, LS_K = 2048, LS_V = 3072, LS_OP = 5120, LS_SS = 13312;
__device__ __forceinline__ void p2s_unit(unsigned char* lds, int unit, const bf16* P, const float* wup, const float* bgk, const float* gng, const float* state, float* out_state, bf16* MIX, int tid, int lane) {
    float* SA = (float*)(lds + LS_A); float* SQ = (float*)(lds + LS_Q); float* SK = (float*)(lds + LS_K); float* SV = (float*)(lds + LS_V); float* OP = (float*)(lds + LS_OP); float* SS = (float*)(lds + LS_SS);
    const int b = unit >> 2, h = unit & 3;
    const int rbase = NPROMPT + b * 4;
    if (tid < 256) { const int t = tid >> 6, k = tid & 63; const bf16* prow = P + (size_t)(rbase + t) * NINP;
        float x = bgk[h * 64 + k];
#pragma unroll
        for (int r = 0; r < 16; ++r) x += bf2f(prow[C_LR + r]) * wup[r * 256 + h * 64 + k];
        SA[t * 64 + k] = __expf(logsigmoid(x) * 0.0625f); SQ[t * 64 + k] = bf2f(prow[C_Q + h * 64 + k]) * 0.125f; SK[t * 64 + k] = bf2f(prow[C_K + h * 64 + k]); }
    { const int t = tid >> 7, dv = tid & 127; SV[t * 128 + dv] = bf2f(P[(size_t)(rbase + t) * NINP + C_V + h * 128 + dv]); }
    __syncthreads();
    {
        const int dv = tid & 127, kg = tid >> 7;
        const size_t sb = ((size_t)(b * 4 + h) * 64 + kg * 16) * 128 + dv;
        float S[16];
#pragma unroll
        for (int i = 0; i < 16; ++i) S[i] = state[sb + i * 128];
#pragma unroll
        for (int t = 0; t < 4; ++t) { const float vv = SV[t * 128 + dv]; float po = 0.f;
#pragma unroll
            for (int i = 0; i < 16; ++i) { const int dk = kg * 16 + i; S[i] = SA[t * 64 + dk] * S[i] + SK[t * 64 + dk] * vv; po += SQ[t * 64 + dk] * S[i]; }
            OP[(t * 4 + kg) * 128 + dv] = po; }
#pragma unroll
        for (int i = 0; i < 16; ++i) out_state[sb + i * 128] = S[i];
    }
    __syncthreads();
    const int t = tid >> 7, dv = tid & 127;
    const float o = (OP[(t * 4 + 0) * 128 + dv] + OP[(t * 4 + 1) * 128 + dv]) + (OP[(t * 4 + 2) * 128 + dv] + OP[(t * 4 + 3) * 128 + dv]);
    { const float ss = wave_sum(o * o); if (lane == 0) SS[t * 2 + ((tid >> 6) & 1)] = ss; }
    __syncthreads();
    { const float rs = 1.f / sqrtf((SS[t * 2] + SS[t * 2 + 1]) * (1.f / 128.f) + EPS);
      const float g = bf2f(P[(size_t)(rbase + t) * NINP + C_G + h * 128 + dv]);
      MIX[(size_t)(rbase + t) * 1024 + h * 128 + dv] = (bf16)f2bf(o * rs * gng[dv] * silu(g)); }
    __syncthreads();
}

__device__ __forceinline__ void load8bf(const bf16* p, float* o) { const u32x4 w = *(const u32x4*)p;
#pragma unroll
    for (int j = 0; j < 4; ++j) { o[2 * j] = blo(w[j]); o[2 * j + 1] = bhi(w[j]); } }
__device__ __forceinline__ void load8f(const float* p, float* o) { const f32x4 a = *(const f32x4*)p, b = *(const f32x4*)(p + 4);
#pragma unroll
    for (int j = 0; j < 4; ++j) { o[j] = a[j]; o[4 + j] = b[j]; } }
__device__ __forceinline__ void conv_item(int it, const bf16* P, const float* state_conv, const float* conv_w, bf16* MIX, float* out_conv_p, float* out_conv_s) {
    const int m = it >> 6, c0 = (it & 63) * 8;
    const bool samp = m >= NPROMPT;
    int b, t, L; if (!samp) { b = m >> 11; t = m & 2047; L = 2048; } else { b = (m - NPROMPT) >> 2; t = (m - NPROMPT) & 3; L = 4; }
    float acc[8], hcur[8];
#pragma unroll
    for (int j = 0; j < 8; ++j) { acc[j] = 0.f; hcur[j] = 0.f; }
#pragma unroll
    for (int jj = 0; jj < 3; ++jj) {
        const int idx = t + jj - 2; float hv[8];
        if (idx >= 0) { const bf16* prow = P + (size_t)(m + jj - 2) * NINP; float u[8], c[8]; load8bf(prow + C_U + c0, u); load8bf(prow + C_C + c0, c);
#pragma unroll
            for (int j = 0; j < 8; ++j) hv[j] = u[j] * c[j]; }
        else if (samp) load8f(state_conv + (size_t)(b * 2 + (t + jj)) * 512 + c0, hv);
        else {
#pragma unroll
            for (int j = 0; j < 8; ++j) hv[j] = 0.f; }
        float wv[8]; load8f(conv_w + jj * 512 + c0, wv);
#pragma unroll
        for (int j = 0; j < 8; ++j) { acc[j] += wv[j] * hv[j]; if (jj == 2) hcur[j] = hv[j]; }
    }
    const bf16* prow = P + (size_t)m * NINP; float bg[8], gc[8]; load8bf(prow + C_B + c0, bg); load8bf(prow + C_GC + c0, gc);
    u32x4 o;
#pragma unroll
    for (int j = 0; j < 4; ++j) o[j] = pk2(bg[2 * j] * acc[2 * j] * silu(gc[2 * j]), bg[2 * j + 1] * acc[2 * j + 1] * silu(gc[2 * j + 1]));
    *(u32x4*)(MIX + (size_t)m * 1024 + 512 + c0) = o;
    if (t >= L - 2) { float* dst = (samp ? out_conv_s : out_conv_p) + (size_t)(b * 2 + (t - (L - 2))) * 512 + c0;
        *(f32x4*)dst = (f32x4){hcur[0], hcur[1], hcur[2], hcur[3]}; *(f32x4*)(dst + 4) = (f32x4){hcur[4], hcur[5], hcur[6], hcur[7]}; }
}

constexpr int LC_QE = 0, LC_ST = 9216, LC_SS = 27648;
__device__ __forceinline__ void p2c_unit(unsigned char* lds, int unit, const bf16* P, const bf16* QEg, const bf16* SNg, const float* OIg, const float* gng, bf16* MIX, int tid, int w, int lane) {
    bf16* QE_s = (bf16*)(lds + LC_QE); bf16* ST_s = (bf16*)(lds + LC_ST); float* SS = (float*)(lds + LC_SS);
    const int bh = unit >> 5, n = unit & 31, b = bh >> 2, h = bh & 3;
    const int r0 = b * 2048 + n * 64;
    { const int t = tid >> 3, kg = tid & 7;
      *(u32x4*)(QE_s + t * 72 + kg * 8) = *(const u32x4*)(QEg + (size_t)unit * 4096 + t * 64 + kg * 8);
      const bf16* sp = SNg + (size_t)unit * 8192 + t * 128 + kg * 16;
      const u32x4 s0 = *(const u32x4*)sp, s1 = *(const u32x4*)(sp + 8);
#pragma unroll
      for (int j = 0; j < 4; ++j) { ST_s[(kg * 16 + 2 * j) * 72 + t] = (bf16)(s0[j] & 0xffffu); ST_s[(kg * 16 + 2 * j + 1) * 72 + t] = (bf16)(s0[j] >> 16);
          ST_s[(kg * 16 + 8 + 2 * j) * 72 + t] = (bf16)(s1[j] & 0xffffu); ST_s[(kg * 16 + 8 + 2 * j + 1) * 72 + t] = (bf16)(s1[j] >> 16); } }
    __syncthreads();
    const int fr = lane & 15, fq = lane >> 4, mt = w >> 1;
    f32x4 acc[4]; float ss[4] = {0.f, 0.f, 0.f, 0.f};
#pragma unroll
    for (int qd = 0; qd < 4; ++qd) { const int nt = (w & 1) * 4 + qd;
        acc[qd] = tile_mma(QE_s, 72, ST_s, 72, mt * 16, nt * 16, 64, lane);
#pragma unroll
        for (int j = 0; j < 4; ++j) { acc[qd][j] += OIg[(size_t)unit * 8192 + (mt * 16 + fq * 4 + j) * 128 + nt * 16 + fr]; ss[j] += acc[qd][j] * acc[qd][j]; } }
#pragma unroll
    for (int j = 0; j < 4; ++j) { float s = ss[j]; s += __shfl_xor(s, 1); s += __shfl_xor(s, 2); s += __shfl_xor(s, 4); s += __shfl_xor(s, 8); if (fr == 0) SS[(mt * 16 + fq * 4 + j) * 2 + (w & 1)] = s; }
    __syncthreads();
#pragma unroll
    for (int j = 0; j < 4; ++j) { const int tt = mt * 16 + fq * 4 + j; const float rs = 1.f / sqrtf((SS[tt * 2] + SS[tt * 2 + 1]) * (1.f / 128.f) + EPS);
        const bf16* prow = P + (size_t)(r0 + tt) * NINP + C_G + h * 128; bf16* mrow = MIX + (size_t)(r0 + tt) * 1024 + h * 128;
#pragma unroll
        for (int qd = 0; qd < 4; ++qd) { const int dv = ((w & 1) * 4 + qd) * 16 + fr; mrow[dv] = (bf16)f2bf(acc[qd][j] * rs * gng[dv] * silu(bf2f(prow[dv]))); } }
    __syncthreads();
}


__device__ __forceinline__ void scan_item(int e, const float* __restrict__ KVg, const float* __restrict__ Dg, bf16* __restrict__ SNg, float* __restrict__ outp) {
    const int bh = e >> 12, rem = e & 4095, dk = rem >> 6, dv = (rem & 63) * 2;
    f32x2 S = {0.f, 0.f};
#pragma unroll 1
    for (int n0 = 0; n0 < 32; n0 += 16) {
        f32x2 kv[16]; float d[16];
#pragma unroll
        for (int i = 0; i < 16; ++i) { const int unit = bh * 32 + n0 + i; kv[i] = *(const f32x2*)(KVg + (size_t)unit * 8192 + dk * 128 + dv); d[i] = Dg[unit * 64 + dk]; }
#pragma unroll
        for (int i = 0; i < 16; ++i) { const int unit = bh * 32 + n0 + i; *(unsigned*)(SNg + (size_t)unit * 8192 + dk * 128 + dv) = pk2(S.x, S.y); S = d[i] * S + kv[i]; }
    }
    *(f32x2*)(outp + (size_t)bh * 8192 + dk * 128 + dv) = S;
}

__global__ void __launch_bounds__(NTHR, 2) mk_fwd(Args a) {
    extern __shared__ __attribute__((aligned(16))) unsigned char lds[];
    cg::grid_group grid = cg::this_grid();
    const int tid = threadIdx.x, lane = tid & 63, w = __builtin_amdgcn_readfirstlane(tid >> 6);
    const int G = gridDim.x, bid = blockIdx.x;
    const int gt = bid * NTHR + tid, NT = G * NTHR;
    const int gw = bid * NWAVES + w, NGW = G * NWAVES;
    const float* x_prompt = a.in[0]; const float* x_sample = a.in[1]; const float* state_gla = a.in[2]; const float* state_conv = a.in[3];
    const float* norm_gain = a.in[4]; const float* w_in = a.in[5]; const float* w_gk_up = a.in[6]; const float* b_gk = a.in[7];
    const float* gla_norm_gain = a.in[8]; const float* conv_w = a.in[9]; const float* w_out = a.in[10]; const float* final_gain = a.in[11];
    unsigned char* ws = a.ws; float* out = a.out;
    bf16* WTIN = (bf16*)(ws + WS_WTIN); bf16* WTOUT = (bf16*)(ws + WS_WTOUT); bf16* XN = (bf16*)(ws + WS_XN); bf16* P = (bf16*)(ws + WS_P); bf16* MIX = (bf16*)(ws + WS_MIX);
    bf16* QEg = (bf16*)(ws + WS_QE); float* OIg = (float*)(ws + WS_OI); float* KVg = (float*)(ws + WS_KV); bf16* SNg = (bf16*)(ws + WS_SN); float* Dg = (float*)(ws + WS_D); float* RSS = (float*)(ws + WS_RSS);

    {
        float* scr = (float*)(lds + w * 8448);
        constexpr int I_IN = 16 * 120, I_OUT = 16 * 32;
        for (int it = gw; it < I_IN + I_OUT; it += NGW) {
            if (it < I_IN) p0_transpose_item(w_in, norm_gain, NIN, 120, WTIN, scr, it, lane);
            else p0_transpose_item(w_out, nullptr, 1024, 32, WTOUT, scr, it - I_IN, lane);
        }
        for (int m = gw; m < MROWS; m += NGW) rms_row_to_bf16(m < NPROMPT ? x_prompt + (size_t)m * DM : x_sample + (size_t)(m - NPROMPT) * DM, XN + (size_t)m * DM, lane);
    }
    grid.sync();
    {
        pg8::Gemm g{XN, WTIN, MROWS, NINP, DM}; pg8::StaticOrder S; S.init(MROWS, NINP, G, bid);
        pg8::EpiBf16<0> E{P, NINP, nullptr, 0, 0, 1.f};
        pg8::gemm_phase<pg8::EpiBf16<0>, pg8::StaticOrder, PG8_ALIGN, PG8_SP2>((PG8_LAS unsigned char*)lds, g, S, E);
    }
    grid.sync();
    {
        for (int u = bid; u < NCHUNK_UNITS; u += G) p2a_unit(lds, u, P, w_gk_up, b_gk, QEg, OIg, KVg, Dg, tid, w, lane);
        for (int u = bid; u < NSAMP_UNITS; u += G) p2s_unit(lds, u, P, w_gk_up, b_gk, gla_norm_gain, state_gla, out + O_GLA_S, MIX, tid, lane);
        for (int it = gt; it < MROWS * 64; it += NT) conv_item(it, P, state_conv, conv_w, MIX, out + O_CONV_P, out + O_CONV_S);
    }
    grid.sync();
    {
        for (int e = gt; e < 32 * 4096; e += NT) scan_item(e, KVg, Dg, SNg, out + O_GLA_P);
    }
    grid.sync();
    {
        for (int u = bid; u < NCHUNK_UNITS; u += G) p2c_unit(lds, u, P, QEg, SNg, OIg, gla_norm_gain, MIX, tid, w, lane);
    }
    grid.sync();
    {
        pg8::Gemm g{MIX, WTOUT, MROWS, DM, DM}; pg8::StaticOrder S; S.init(MROWS, DM, G, bid);
        pg8::EpiResF32 E{x_prompt, x_sample, out + O_Y, RSS};
        pg8::gemm_phase<pg8::EpiResF32, pg8::StaticOrder, PG8_ALIGN, PG8_SP2>((PG8_LAS unsigned char*)lds, g, S, E);
    }
    grid.sync();
    {
        for (int m = gw; m < MROWS; m += NGW) {
            float p = lane < 16 ? RSS[(size_t)m * 16 + lane] : 0.f;
            const float rs = 1.f / sqrtf(wave_sum(p) * (1.f / 1024.f) + EPS);
            f32x4* yr = (f32x4*)(out + O_Y + (size_t)m * DM) + lane; const f32x4* gr = (const f32x4*)final_gain + lane;
#pragma unroll
            for (int j = 0; j < 4; ++j) { const f32x4 v = yr[64 * j]; yr[64 * j] = v * rs * gr[64 * j]; }
        }
    }
}

extern "C" void kernel_launch(void* const* d_in, const int* in_sizes, int n_in, void* d_out, int out_size, void* d_ws, size_t ws_size, hipStream_t stream) {
    static int grid = 0;
    if (grid == 0) {
        if (n_in != 12 || ws_size < WS_END) { fprintf(stderr, "kernel_launch: unexpected n_in %d / ws %zu\n", n_in, ws_size); grid = -1; return; }
        int dev = 0, cus = 0, per_cu = 0;
        (void)hipGetDevice(&dev);
        (void)hipDeviceGetAttribute(&cus, hipDeviceAttributeMultiprocessorCount, dev);
        (void)hipFuncSetAttribute((const void*)mk_fwd, hipFuncAttributeMaxDynamicSharedMemorySize, LDS_BYTES);
        (void)hipOccupancyMaxActiveBlocksPerMultiprocessor(&per_cu, (const void*)mk_fwd, NTHR, LDS_BYTES);
        if (per_cu < 1) per_cu = 1;
        grid = cus * per_cu;
    }
    if (grid < 0) return;
    Args a{};
    for (int i = 0; i < 12; ++i) a.in[i] = (const float*)d_in[i];
    a.out = (float*)d_out; a.ws = (unsigned char*)d_ws;
    void* args[] = {&a};
    hipError_t e = hipLaunchCooperativeKernel((const void*)mk_fwd, dim3(grid), dim3(NTHR), args, LDS_BYTES, stream);
    if (e != hipSuccess) fprintf(stderr, "cooperative launch failed: %s (grid %d)\n", hipGetErrorString(e), grid);
}
```

```cpp
#include <hip/hip_runtime.h>
#include <hip/hip_cooperative_groups.h>
#include <cstdio>
#include <cstdint>
namespace cg = cooperative_groups;

namespace pg8 {
#define PG8_LAS __attribute__((address_space(3)))
typedef unsigned short bf16_t;
typedef short bf16x8 __attribute__((ext_vector_type(8)));
typedef float f32x4 __attribute__((ext_vector_type(4)));
typedef unsigned u32x4 __attribute__((ext_vector_type(4)));
constexpr int BM = 256, BK = 64, HALF = 128, HTB = HALF * BK * 2  , STAGE_BYTES = 8 * HTB, NXCD = 8, WGM = 8;

__host__ __device__ __forceinline__ int lds_byte(int r, int c) { const int st = (r >> 4) * 2 + (c >> 5), rr = r & 15, cc = c & 31, ob = rr * 64 + cc * 2; return st * 1024 + (ob ^ (((ob >> 9) & 1) << 5)); }
__host__ __device__ __forceinline__ void stage_rc(int b, int& R, int& C) { const int st = b / 1024, sb = b % 1024, swz = sb ^ (((sb >> 9) & 1) << 5); R = (st >> 1) * 16 + swz / 64; C = (st & 1) * 32 + (swz % 64) / 2; }
__host__ __device__ __forceinline__ int perm32(int rho) { const int n = rho >> 4, i = rho & 15; return 8 * (i >> 2) + 4 * n + (i & 3); }

struct Unit { int pm, pn; };
struct Gemm { const bf16_t* A; const bf16_t* Bt; int M, N, K; };

struct StaticOrder {
    int nM, nN, nwg, G, c;
    __host__ __device__ void init(int M, int N, int G_, int c_) { nM = M / BM; nN = N / BM; nwg = nM * nN; G = G_; c = c_; }
    __host__ __device__ bool next(int i, Unit& u) const {
        const long L = (long)i * G + c; if (L >= nwg) return false;
        int wgid = (int)L; { const int q = nwg / NXCD, r = nwg % NXCD, xcd = wgid % NXCD, off = wgid / NXCD; wgid = (xcd < r ? xcd * (q + 1) : r * (q + 1) + (xcd - r) * q) + off; }
        const int nig = WGM * nN, gid = wgid / nig, fm = gid * WGM, gsz = (nM - fm) < WGM ? (nM - fm) : WGM;
        u.pm = fm + ((wgid % nig) % gsz); u.pn = (wgid % nig) / gsz; return true;
    }
    __device__ __forceinline__ void a_ready(const Unit&) const {}
    __device__ __forceinline__ void done(const Unit&) const {}
};

__device__ __forceinline__ unsigned cvt_pk_bf16(float lo, float hi) { unsigned r; asm volatile("v_cvt_pk_bf16_f32 %0, %1, %2" : "=v"(r) : "v"(lo), "v"(hi)); return r; }
template <int ACT  > struct EpiBf16 {
    static constexpr bool PERM = true, AFTER_DRAIN = false; static_assert(ACT == 0 || ACT == 1, "EpiBf16: ACT is 0 (none) or 1 (gelu_pk)");
    bf16_t* O; int ldc; const float* bias; int split_cols; size_t split_stride; float scale0;
    __device__ __forceinline__ void operator()(const f32x4 (&acc)[2][2][4][2], const Unit& u, int wr, int wc, int fr, int fq) const {
        const int row0 = u.pm * BM + wr * 64 + fr; int colt = u.pn * BM; bf16_t* base = O;
        float sc = 1.f; if (split_cols) { const int t = colt / split_cols; base += (size_t)t * split_stride; colt -= t * split_cols; if (t == 0) sc = scale0; }
        const int col0 = colt + wc * 32 + 8 * fq, bcol0 = u.pn * BM + wc * 32 + 8 * fq;
        f32x4 bv[2][2];
#pragma unroll
        for (int bj = 0; bj < 2; ++bj)
#pragma unroll
            for (int n = 0; n < 2; ++n) bv[bj][n] = bias ? *(const f32x4*)(bias + bcol0 + bj * HALF + 4 * n) : (f32x4){0.f, 0.f, 0.f, 0.f};
#pragma unroll
        for (int ai = 0; ai < 2; ++ai)
#pragma unroll
            for (int m = 0; m < 4; ++m) { bf16_t* rowp = base + (size_t)(row0 + ai * HALF + m * 16) * ldc + col0;
#pragma unroll
                for (int bj = 0; bj < 2; ++bj) { f32x4 v0 = acc[ai][bj][m][0] + bv[bj][0], v1 = acc[ai][bj][m][1] + bv[bj][1];
                    v0 = v0 * sc; v1 = v1 * sc; u32x4 w; w.x = cvt_pk_bf16(v0[0], v0[1]); w.y = cvt_pk_bf16(v0[2], v0[3]); w.z = cvt_pk_bf16(v1[0], v1[1]); w.w = cvt_pk_bf16(v1[2], v1[3]);
                    *(u32x4*)(rowp + bj * HALF) = w; } }
    }
};
struct EpiResF32 {
    static constexpr bool PERM = false, AFTER_DRAIN = false;
    const float* xp; const float* xs; float* out; float* rss;
    __device__ __forceinline__ void operator()(const f32x4 (&acc)[2][2][4][2], const Unit& u, int wr, int wc, int fr, int fq) const {
        const int row0 = u.pm * BM + wr * 64 + fr, col0 = u.pn * BM + wc * 32 + 4 * fq;
        const float* xb = (u.pm < 64) ? xp : xs; const int roff = (u.pm < 64) ? 0 : 16384;
#pragma unroll
        for (int ai = 0; ai < 2; ++ai)
#pragma unroll
            for (int m = 0; m < 4; ++m) { const int row = row0 + ai * HALF + m * 16; const float* xr = xb + (size_t)(row - roff) * 1024 + col0; float* orow = out + (size_t)row * 1024 + col0; float ss = 0.f;
#pragma unroll
                for (int bj = 0; bj < 2; ++bj)
#pragma unroll
                    for (int n = 0; n < 2; ++n) { const f32x4 xv = *(const f32x4*)(xr + bj * HALF + n * 16); const f32x4 o = acc[ai][bj][m][n] + xv;
                        ss += (o[0] * o[0] + o[1] * o[1]) + (o[2] * o[2] + o[3] * o[3]); *(f32x4*)(orow + bj * HALF + n * 16) = o; }
                ss += __shfl_xor(ss, 16); ss += __shfl_xor(ss, 32);
                if (fq == 0) rss[(size_t)row * 16 + u.pn * 4 + wc] = ss; }
    }
};
template <class Epi, class Sched, bool ALIGN_EPI = false, bool SP2 = false>
__device__ __forceinline__ void gemm_phase(PG8_LAS unsigned char* lds, const Gemm g, const Sched& S, const Epi& E) {
    const int tid = threadIdx.x, wid = __builtin_amdgcn_readfirstlane(tid >> 6), lane = tid & 63, wr = wid >> 2, wc = wid & 3, fr = lane & 15, fq = lane >> 4;
    const int K = g.K, nt = K / BK;
    unsigned voffA[2], voffB[2];
#pragma unroll
    for (int i = 0; i < 2; ++i) { int R, C; stage_rc(tid * 16 + i * 8192, R, C); const int Rb = Epi::PERM ? ((R & ~31) + perm32(R & 31)) : R;
        voffA[i] = (unsigned)(R * K + C) * 2u; voffB[i] = (unsigned)(Rb * K + C) * 2u; }
    const size_t kstep = (size_t)(BK * 2);
    const size_t hstep = (size_t)HALF * K * 2;
    const size_t tstep = 2 * hstep;
    const unsigned ldsw = (unsigned)wid * 1024u;
    const int aoff = lds_byte(wr * 64 + fr, fq * 8), boff = lds_byte(wc * 32 + fr, fq * 8);
#define PG8_SA(b, h) (((b) * 2 + (h)) * HTB)
#define PG8_SB(b, h) ((4 + (b) * 2 + (h)) * HTB)
#define PG8_STAGE(bufoff, gbase, voff) do { _Pragma("unroll") for (int _i = 0; _i < 2; ++_i) \
        __builtin_amdgcn_global_load_lds((const unsigned*)((const char*)(gbase) + (voff)[_i]), (PG8_LAS unsigned*)(lds + (bufoff) + ldsw + _i * 8192), 16, 0, 0); } while (0)
#define PG8_LDA(dst, b, h) do { _Pragma("unroll") for (int m = 0; m < 4; ++m) _Pragma("unroll") for (int k = 0; k < 2; ++k) dst[m][k] = *(const PG8_LAS bf16x8*)(lds + PG8_SA(b, h) + aoff + m * 2048 + k * 1024); } while (0)
#define PG8_LDB(dst, b, h) do { _Pragma("unroll") for (int n = 0; n < 2; ++n) _Pragma("unroll") for (int k = 0; k < 2; ++k) dst[n][k] = *(const PG8_LAS bf16x8*)(lds + PG8_SB(b, h) + boff + n * 2048 + k * 1024); } while (0)
#define PG8_MMA(ai, bj, At, Bt) do { __builtin_amdgcn_s_setprio(1); _Pragma("unroll") for (int m = 0; m < 4; ++m) _Pragma("unroll") for (int n = 0; n < 2; ++n) _Pragma("unroll") for (int k = 0; k < 2; ++k) \
        acc[ai][bj][m][n] = __builtin_amdgcn_mfma_f32_16x16x32_bf16(Bt[n][k], At[m][k], acc[ai][bj][m][n], 0, 0, 0); __builtin_amdgcn_s_setprio(0); } while (0)
#define PG8_WAIT_V(n) asm volatile("s_waitcnt vmcnt(" #n ")" ::: "memory")
#define PG8_WAIT_L(n) asm volatile("s_waitcnt lgkmcnt(" #n ")" ::: "memory")
#define PG8_BAR __builtin_amdgcn_s_barrier()
#define PG8_SCHED __builtin_amdgcn_sched_barrier(0)
    Unit cur, nxt; int ui = 0;
    if (!S.next(0, cur)) return;
    f32x4 acc[2][2][4][2];
#pragma unroll
    for (int a = 0; a < 2; ++a)
#pragma unroll
        for (int b = 0; b < 2; ++b)
#pragma unroll
            for (int m = 0; m < 4; ++m)
#pragma unroll
                for (int n = 0; n < 2; ++n) acc[a][b][m][n] = (f32x4){0.f, 0.f, 0.f, 0.f};
    bf16x8 At[4][2], B0[2][2], B1[2][2];
    const char* cA = (const char*)g.A + (size_t)cur.pm * tstep; const char* cB = (const char*)g.Bt + (size_t)cur.pn * tstep;
    S.a_ready(cur);
    if constexpr (SP2) {
        PG8_STAGE(PG8_SB(0, 0), cB, voffB); PG8_STAGE(PG8_SB(0, 1), cB + hstep, voffB); PG8_STAGE(PG8_SA(0, 0), cA, voffA); PG8_STAGE(PG8_SA(0, 1), cA + hstep, voffA);
        if (wr == 1) PG8_BAR;
        PG8_WAIT_V(2); PG8_BAR;
        PG8_STAGE(PG8_SB(1, 0), cB + kstep, voffB); PG8_STAGE(PG8_SA(1, 0), cA + kstep, voffA); PG8_STAGE(PG8_SB(1, 1), cB + hstep + kstep, voffB);
        PG8_WAIT_V(6); PG8_BAR;
    } else {
        PG8_STAGE(PG8_SB(0, 0), cB, voffB); PG8_STAGE(PG8_SA(0, 0), cA, voffA); PG8_STAGE(PG8_SB(0, 1), cB + hstep, voffB); PG8_STAGE(PG8_SA(0, 1), cA + hstep, voffA);
        if (wr == 1) PG8_BAR;
        PG8_WAIT_V(4); PG8_BAR;
        PG8_STAGE(PG8_SB(1, 0), cB + kstep, voffB); PG8_STAGE(PG8_SA(1, 0), cA + kstep, voffA); PG8_STAGE(PG8_SB(1, 1), cB + hstep + kstep, voffB);
        PG8_WAIT_V(6); PG8_BAR;
    }
    for (;;) {
        const bool has_next = S.next(ui + 1, nxt);
        const char* nA = has_next ? (const char*)g.A + (size_t)nxt.pm * tstep : cA; const char* nB = has_next ? (const char*)g.Bt + (size_t)nxt.pn * tstep : cB;
        for (int t = 0; t < nt; t += 2) {
            const bool last = (t == nt - 2);
            const char* a1 = cA + (size_t)(t + 1) * kstep;
            const char* a2 = last ? nA : cA + (size_t)(t + 2) * kstep; const char* b2 = last ? nB : cB + (size_t)(t + 2) * kstep;
            const char* a3 = a2 + kstep; const char* b3 = b2 + kstep;
            if (last && has_next) S.a_ready(nxt);
            if constexpr (SP2) {
            PG8_LDB(B0, 0, 0); PG8_LDB(B1, 0, 1); PG8_SCHED; PG8_LDA(At, 0, 0); PG8_STAGE(PG8_SA(1, 1), a1 + hstep, voffA);
            PG8_WAIT_V(8); PG8_WAIT_L(0); PG8_BAR; PG8_MMA(0, 0, At, B0); PG8_MMA(0, 1, At, B1); PG8_BAR; PG8_SCHED;
            PG8_LDA(At, 0, 1); PG8_STAGE(PG8_SB(0, 0), b2, voffB); PG8_STAGE(PG8_SB(0, 1), b2 + hstep, voffB); PG8_STAGE(PG8_SA(0, 0), a2, voffA);
            PG8_WAIT_V(8); PG8_WAIT_L(0); PG8_BAR; PG8_MMA(1, 0, At, B0); PG8_MMA(1, 1, At, B1); PG8_BAR; PG8_SCHED;
            PG8_LDB(B0, 1, 0); PG8_LDB(B1, 1, 1); PG8_SCHED; PG8_LDA(At, 1, 0); PG8_STAGE(PG8_SA(0, 1), a2 + hstep, voffA);
            PG8_WAIT_V(8); PG8_WAIT_L(0); PG8_BAR; PG8_MMA(0, 0, At, B0); PG8_MMA(0, 1, At, B1); PG8_BAR; PG8_SCHED;
            PG8_LDA(At, 1, 1); PG8_STAGE(PG8_SB(1, 0), b3, voffB); PG8_STAGE(PG8_SB(1, 1), b3 + hstep, voffB); PG8_STAGE(PG8_SA(1, 0), a3, voffA);
            PG8_WAIT_V(8); PG8_WAIT_L(0); PG8_BAR; PG8_MMA(1, 0, At, B0); PG8_MMA(1, 1, At, B1); PG8_BAR; PG8_SCHED;
            } else {
            PG8_LDB(B0, 0, 0); PG8_SCHED; PG8_LDA(At, 0, 0); PG8_STAGE(PG8_SA(1, 1), a1 + hstep, voffA);
            PG8_WAIT_L(8); PG8_BAR; PG8_WAIT_L(0); PG8_MMA(0, 0, At, B0); PG8_BAR; PG8_SCHED;
            PG8_LDB(B1, 0, 1); PG8_STAGE(PG8_SB(0, 0), b2, voffB);
            PG8_BAR; PG8_WAIT_L(0); PG8_MMA(0, 1, At, B1); PG8_BAR;
            PG8_LDA(At, 0, 1); PG8_STAGE(PG8_SA(0, 0), a2, voffA);
            PG8_BAR; PG8_WAIT_L(0); PG8_MMA(1, 0, At, B0); PG8_BAR; PG8_SCHED;
            PG8_STAGE(PG8_SB(0, 1), b2 + hstep, voffB);
            PG8_WAIT_V(6); PG8_BAR; PG8_MMA(1, 1, At, B1); PG8_BAR;
            PG8_LDB(B0, 1, 0); PG8_SCHED; PG8_LDA(At, 1, 0); PG8_STAGE(PG8_SA(0, 1), a2 + hstep, voffA);
            PG8_WAIT_L(8); PG8_BAR; PG8_WAIT_L(0); PG8_MMA(0, 0, At, B0); PG8_BAR; PG8_SCHED;
            PG8_LDB(B1, 1, 1); PG8_STAGE(PG8_SB(1, 0), b3, voffB);
            PG8_BAR; PG8_WAIT_L(0); PG8_MMA(0, 1, At, B1); PG8_BAR;
            PG8_LDA(At, 1, 1); PG8_STAGE(PG8_SA(1, 0), a3, voffA);
            PG8_BAR; PG8_WAIT_L(0); PG8_MMA(1, 0, At, B0); PG8_BAR; PG8_SCHED;
            PG8_STAGE(PG8_SB(1, 1), b3 + hstep, voffB);
            PG8_WAIT_V(6); PG8_BAR; PG8_MMA(1, 1, At, B1); PG8_BAR;
            }
        }
        if constexpr (ALIGN_EPI) { if (wr == 0) PG8_BAR; }
        if constexpr (!Epi::AFTER_DRAIN) { E(acc, cur, wr, wc, fr, fq); S.done(cur); }
        if (!has_next) break;
#pragma unroll
        for (int a = 0; a < 2; ++a)
#pragma unroll
            for (int b = 0; b < 2; ++b)
#pragma unroll
                for (int m = 0; m < 4; ++m)
#pragma unroll
                    for (int n = 0; n < 2; ++n) acc[a][b][m][n] = (f32x4){0.f, 0.f, 0.f, 0.f};
        cur = nxt; cA = nA; cB = nB; ++ui;
        if constexpr (ALIGN_EPI) { if (wr == 1) PG8_BAR; }
    }
    PG8_WAIT_V(0);
    if constexpr (!ALIGN_EPI) { if (wr == 0) PG8_BAR; }
    PG8_BAR;
    if constexpr (Epi::AFTER_DRAIN) { E.fused(acc, cur, wr, wc, fr, fq, lds, wid, lane); S.done(cur); }
#undef PG8_SA
#undef PG8_SB
#undef PG8_STAGE
#undef PG8_LDA
#undef PG8_LDB
#undef PG8_MMA
#undef PG8_WAIT_V
#undef PG8_WAIT_L
#undef PG8_BAR
#undef PG8_SCHED
}
}

#ifndef REP0
#define REP0 1
#endif
#ifndef REP1
#define REP1 1
#endif
#ifndef REP2A
#define REP2A 1
#endif
#ifndef REP2B
#define REP2B 1
#endif
#ifndef REP2C
#define REP2C 1
#endif
#ifndef REP3
#define REP3 1
#endif
#ifndef REPSYNC
#define REPSYNC 0
#endif
#ifndef PG8_SP2
#define PG8_SP2 true
#endif
#ifndef PG8_ALIGN
#define PG8_ALIGN true
#endif

typedef unsigned short bf16;
typedef short bf16x8 __attribute__((ext_vector_type(8)));
typedef float f32x4 __attribute__((ext_vector_type(4)));
typedef float f32x2 __attribute__((ext_vector_type(2)));
typedef unsigned u32x4 __attribute__((ext_vector_type(4)));
typedef unsigned u32x2 __attribute__((ext_vector_type(2)));
#define LAS __attribute__((address_space(3)))

constexpr int NWAVES = 8, NTHR = 512;
constexpr int DM = 1024, NPROMPT = 16384, MROWS = 16896, NIN = 3600, NINP = 3840;
constexpr int C_Q = 0, C_K = 256, C_V = 512, C_G = 1024, C_LR = 1536, C_U = 1552, C_B = 2064, C_C = 2576, C_GC = 3088;
constexpr float EPS = 1e-6f;
constexpr int NCHUNK_UNITS = 1024;
constexpr int NSAMP_UNITS = 512;
constexpr size_t O_Y = 0, O_GLA_P = 17301504, O_CONV_P = 17563648, O_GLA_S = 17571840, O_CONV_S = 21766144;
constexpr size_t MiB = 1u << 20;
constexpr size_t WS_WTIN = 2 * MiB;
constexpr size_t WS_QE = 2 * MiB;
constexpr size_t WS_WTOUT = 10 * MiB;
constexpr size_t WS_XN = 12 * MiB;
constexpr size_t WS_OI = 12 * MiB;
constexpr size_t WS_D = 44 * MiB;
constexpr size_t WS_RSS = 45 * MiB;
constexpr size_t WS_P = 47 * MiB;
constexpr size_t WS_MIX = 171 * MiB;
constexpr size_t WS_KV = 204 * MiB;
constexpr size_t WS_SN = 236 * MiB;
constexpr size_t WS_END = 252 * MiB;
constexpr int LDS_BYTES = 147456, LDS_ST_OFF = 131072 + 64;
#ifdef USE_CG_SYNC
#define GRID_BAR() grid.sync()
#else
#define GRID_BAR() xcd_barrier(bar)
#endif
constexpr size_t CTL_ZERO_BYTES = 16384;

__device__ __forceinline__ float bf2f(unsigned b) { return __uint_as_float(b << 16); }
__device__ __forceinline__ unsigned f2bf(float f) { unsigned u = __float_as_uint(f); return (u + 0x7fffu + ((u >> 16) & 1u)) >> 16; }
__device__ __forceinline__ unsigned pk2(float lo, float hi) { return pg8::cvt_pk_bf16(lo, hi); }
__device__ __forceinline__ float blo(unsigned w) { return __uint_as_float(w << 16); }
__device__ __forceinline__ float bhi(unsigned w) { return __uint_as_float(w & 0xffff0000u); }
__device__ __forceinline__ float wave_sum(float v) {
#pragma unroll
    for (int o = 1; o < 64; o <<= 1) v += __shfl_xor(v, o);
    return v;
}
__device__ __forceinline__ float silu(float x) { return x / (1.f + __expf(-x)); }
__device__ __forceinline__ float logsigmoid(float x) { return fminf(x, 0.f) - log1pf(expf(-fabsf(x))); }
#define LDS_WAIT() asm volatile("s_waitcnt lgkmcnt(0)" ::: "memory")

struct Args { const float* in[12]; float* out; unsigned char* ws; };

__device__ __forceinline__ f32x4 tile_mma(const bf16* A, int lda, const bf16* Bt, int ldb, int m0, int n0, int K, int lane) {
    f32x4 acc = {0.f, 0.f, 0.f, 0.f};
    const int fr = lane & 15, fq = lane >> 4;
#pragma unroll
    for (int k0 = 0; k0 < 64; k0 += 32) {
        if (k0 < K) {
            const bf16x8 a = *(const bf16x8*)(A + (m0 + fr) * lda + k0 + fq * 8);
            const bf16x8 b = *(const bf16x8*)(Bt + (n0 + fr) * ldb + k0 + fq * 8);
            acc = __builtin_amdgcn_mfma_f32_16x16x32_bf16(a, b, acc, 0, 0, 0);
        }
    }
    return acc;
}

#define RLX_AGENT __ATOMIC_RELAXED, __HIP_MEMORY_SCOPE_AGENT
#define XB_TMO      128
#define XB_XCNT(j)  (256  + 64 * (j))
#define XB_XSUB(j)  (1280 + 64 * (j))
#define XB_XGEN(j)  (2304 + 64 * (j))
#define XB_TOP      3328
#define XB_TOPGEN   3392
#define XCD_BAR_WORDS 3456
#define XB_SPIN_CAP (1u << 18)

__device__ __forceinline__ unsigned xb_ld(unsigned* p)              { return __hip_atomic_load(p, __ATOMIC_RELAXED, __HIP_MEMORY_SCOPE_AGENT); }
__device__ __forceinline__ unsigned xb_add(unsigned* p, unsigned v) { return __hip_atomic_fetch_add(p, v, __ATOMIC_RELAXED, __HIP_MEMORY_SCOPE_AGENT); }
__device__ __forceinline__ unsigned xb_xcc_id() { return (unsigned)__builtin_amdgcn_s_getreg((3 << 11) | 20) & 0xFu; }
#define XB_SPIN(cond, bar) do { unsigned _sp = 0; while (cond) { __builtin_amdgcn_s_sleep(1); \
    if ((++_sp & 255u) == 0u) { if (xb_ld(&(bar)[XB_TMO])) break; if (_sp > XB_SPIN_CAP) { atomicAdd(&(bar)[XB_TMO], 1u); break; } } } } while (0)

struct XcdBarrier {
    unsigned* bar; unsigned x;
    volatile LAS unsigned* st;
};

__device__ __forceinline__ XcdBarrier xcd_barrier_post(unsigned* bar, volatile LAS unsigned* st) {
    XcdBarrier b; b.bar = bar; b.x = xb_xcc_id(); b.st = st;
    if (threadIdx.x == 0) (void)xb_add(&bar[XB_XCNT(b.x)], 1u);
    return b;
}
__device__ __forceinline__ void xcd_barrier_complete(unsigned* bar, unsigned x, unsigned& nloc, unsigned& nx) {
    const unsigned G = gridDim.x * gridDim.y * gridDim.z;
    unsigned sum, cnt, mine, sp = 0u;
    for (;;) {
        sum = 0u; cnt = 0u; mine = 0u;
#pragma unroll
        for (unsigned j = 0; j < 16; ++j) { const unsigned c = xb_ld(&bar[XB_XCNT(j)]); sum += c; cnt += (c > 0u) ? 1u : 0u; mine = (j == x) ? c : mine; }
        if (sum == G) break;
        __builtin_amdgcn_s_sleep(1);
        if ((++sp & 255u) == 0u) { if (xb_ld(&bar[XB_TMO])) break; if (sp > XB_SPIN_CAP) { atomicAdd(&bar[XB_TMO], 1u); break; } }
    }
    nloc = mine > 0u ? mine : 1u; nx = cnt > 0u ? cnt : 1u;
}

__device__ __forceinline__ void xcd_barrier(const XcdBarrier& b) {
    asm volatile("s_waitcnt vmcnt(0)" ::: "memory");
    __syncthreads();
    if (threadIdx.x == 0) {
        unsigned* bar = b.bar;
        __builtin_amdgcn_s_waitcnt(0);
        unsigned nloc = b.st[0], nx = b.st[1];
        if (nloc == 0u) { xcd_barrier_complete(bar, b.x, nloc, nx); b.st[0] = nloc; b.st[1] = nx; }
        const unsigned old = xb_add(&bar[XB_XSUB(b.x)], 1u);
        const unsigned gen = old / nloc;
        if (old + 1u == (gen + 1u) * nloc) {
            __builtin_amdgcn_fence(__ATOMIC_RELEASE, "agent");
            asm volatile("s_waitcnt vmcnt(0)" ::: "memory");
            const unsigned og = xb_add(&bar[XB_TOP], 1u);
            const unsigned tg = og / nx;
            if (og + 1u == (tg + 1u) * nx) xb_add(&bar[XB_TOPGEN], 1u);
            else XB_SPIN(xb_ld(&bar[XB_TOPGEN]) == tg, bar);
            __builtin_amdgcn_fence(__ATOMIC_ACQUIRE, "agent");
            xb_add(&bar[XB_XGEN(b.x)], 1u);
            asm volatile("s_waitcnt vmcnt(0)" ::: "memory");
        } else {
            XB_SPIN(xb_ld(&bar[XB_XGEN(b.x)]) == gen, bar);
            __builtin_amdgcn_fence(__ATOMIC_ACQUIRE, "agent");
            asm volatile("s_waitcnt vmcnt(0)" ::: "memory");
        }
    }
    __syncthreads();
}

__device__ __forceinline__ void p0_transpose_item(const float* W, const float* gain, int N, int nblk, bf16* WT, float* scr, int item, int lane) {
    const int kb = item / nblk, nb = item % nblk, k0 = 64 * kb, n0 = 32 * nb;
    const int nn = n0 + (lane & 31);
#pragma unroll 8
    for (int i = 0; i < 32; ++i) { const int kk = 2 * i + (lane >> 5); float v = 0.f; if (nn < N) v = W[(size_t)(k0 + kk) * N + nn]; if (gain) v *= gain[k0 + kk]; scr[kk * 33 + (lane & 31)] = v; }
    LDS_WAIT(); asm volatile("" ::: "memory");
    const int c = lane & 7;
#pragma unroll
    for (int j = 0; j < 4; ++j) { const int n = (lane >> 3) + 8 * j; const float* s = scr + (8 * c) * 33 + n;
        u32x4 o; o.x = pk2(s[0 * 33], s[1 * 33]); o.y = pk2(s[2 * 33], s[3 * 33]); o.z = pk2(s[4 * 33], s[5 * 33]); o.w = pk2(s[6 * 33], s[7 * 33]);
        *(u32x4*)(WT + (size_t)(n0 + n) * 1024 + k0 + 8 * c) = o; }
    LDS_WAIT(); asm volatile("" ::: "memory");
}
__device__ __forceinline__ void rms_row_to_bf16(const float* xrow, bf16* orow, int lane) {
    const f32x4* xr = (const f32x4*)xrow + lane;
    f32x4 v[4]; float s = 0.f;
#pragma unroll
    for (int j = 0; j < 4; ++j) { v[j] = xr[64 * j]; s += (v[j].x * v[j].x + v[j].y * v[j].y) + (v[j].z * v[j].z + v[j].w * v[j].w); }
    const float rs = 1.f / sqrtf(wave_sum(s) * (1.f / 1024.f) + EPS);
    u32x2* o8 = (u32x2*)orow + lane;
#pragma unroll
    for (int j = 0; j < 4; ++j) { u32x2 o; o.x = pk2(v[j].x * rs, v[j].y * rs); o.y = pk2(v[j].z * rs, v[j].w * rs); o8[64 * j] = o; }
}

constexpr int L_G = 0, L_SEGT = 17408, L_BL = 19456, L_QE = 19712, L_KD = 28928, L_KET = 38144, L_AS = 47360, L_VT = 56576;
__device__ __forceinline__ void p2a_unit(unsigned char* lds, int unit, const bf16* P, const float* wup, const float* bgk, bf16* QEg, float* OIg, float* KVg, float* Dg, int tid, int w, int lane) {
    float* G = (float*)(lds + L_G); float* SEGT = (float*)(lds + L_SEGT); float* BL = (float*)(lds + L_BL);
    bf16* QE_s = (bf16*)(lds + L_QE); bf16* KD_s = (bf16*)(lds + L_KD); bf16* KET_s = (bf16*)(lds + L_KET); bf16* A_s = (bf16*)(lds + L_AS); bf16* VT_s = (bf16*)(lds + L_VT);
    const int bh = unit >> 5, n = unit & 31, b = bh >> 2, h = bh & 3;
    const int r0 = b * 2048 + n * 64;
    const int t = tid >> 3, kg = tid & 7;
    const bf16* prow = P + (size_t)(r0 + t) * NINP;
    const u32x4 lr0 = *(const u32x4*)(prow + C_LR), lr1 = *(const u32x4*)(prow + C_LR + 8);
    const u32x4 qv = *(const u32x4*)(prow + C_Q + h * 64 + kg * 8);
    const u32x4 kv = *(const u32x4*)(prow + C_K + h * 64 + kg * 8);
    const u32x4 v0 = *(const u32x4*)(prow + C_V + h * 128 + kg * 16), v1 = *(const u32x4*)(prow + C_V + h * 128 + kg * 16 + 8);
    {
        float lr[16];
#pragma unroll
        for (int i = 0; i < 4; ++i) { lr[2 * i] = blo(lr0[i]); lr[2 * i + 1] = bhi(lr0[i]); lr[8 + 2 * i] = blo(lr1[i]); lr[8 + 2 * i + 1] = bhi(lr1[i]); }
        const float* bp = bgk + h * 64 + kg * 8;
        f32x4 x0 = *(const f32x4*)bp, x1 = *(const f32x4*)(bp + 4);
#pragma unroll
        for (int r = 0; r < 16; ++r) { const float* wr = wup + r * 256 + h * 64 + kg * 8; const f32x4 w0 = *(const f32x4*)wr, w1 = *(const f32x4*)(wr + 4); x0 += lr[r] * w0; x1 += lr[r] * w1; }
        f32x4 g0, g1;
#pragma unroll
        for (int j = 0; j < 4; ++j) { g0[j] = logsigmoid(x0[j]) * 0.0625f; g1[j] = logsigmoid(x1[j]) * 0.0625f; }
        *(f32x4*)(G + t * 68 + kg * 8) = g0; *(f32x4*)(G + t * 68 + kg * 8 + 4) = g1;
    }
    __syncthreads();
    {
        const int k = tid & 63, seg = tid >> 6; float run = 0.f;
#pragma unroll
        for (int i = 0; i < 8; ++i) { run += G[(seg * 8 + i) * 68 + k]; G[(seg * 8 + i) * 68 + k] = run; }
        SEGT[seg * 64 + k] = run;
    }
    __syncthreads();
    {
        const int k = tid & 63, seg = tid >> 6; float off = 0.f, tot = 0.f;
#pragma unroll
        for (int s = 0; s < 8; ++s) { const float v = SEGT[s * 64 + k]; tot += v; if (s < seg) off += v; }
#pragma unroll
        for (int i = 0; i < 8; ++i) G[(seg * 8 + i) * 68 + k] += off;
        if (seg == 0) BL[k] = tot;
    }
    __syncthreads();
    {
        const f32x4 b0 = *(const f32x4*)(G + t * 68 + kg * 8), b1 = *(const f32x4*)(G + t * 68 + kg * 8 + 4);
        const f32x4 l0 = *(const f32x4*)(BL + kg * 8), l1 = *(const f32x4*)(BL + kg * 8 + 4);
        float bb[8], bl[8], q[8], k[8], qe[8], kd[8], ke[8];
#pragma unroll
        for (int j = 0; j < 4; ++j) { bb[j] = b0[j]; bb[4 + j] = b1[j]; bl[j] = l0[j]; bl[4 + j] = l1[j]; q[2 * j] = blo(qv[j]); q[2 * j + 1] = bhi(qv[j]); k[2 * j] = blo(kv[j]); k[2 * j + 1] = bhi(kv[j]); }
#pragma unroll
        for (int j = 0; j < 8; ++j) { qe[j] = q[j] * __expf(bb[j]) * 0.125f; kd[j] = k[j] * __expf(-bb[j]); ke[j] = k[j] * __expf(bl[j] - bb[j]); }
        u32x4 qw, kw;
#pragma unroll
        for (int j = 0; j < 4; ++j) { qw[j] = pk2(qe[2 * j], qe[2 * j + 1]); kw[j] = pk2(kd[2 * j], kd[2 * j + 1]); }
        *(u32x4*)(QE_s + t * 72 + kg * 8) = qw; *(u32x4*)(KD_s + t * 72 + kg * 8) = kw;
        *(u32x4*)(QEg + (size_t)unit * 4096 + t * 64 + kg * 8) = qw;
#pragma unroll
        for (int j = 0; j < 8; ++j) KET_s[(kg * 8 + j) * 72 + t] = (bf16)f2bf(ke[j]);
#pragma unroll
        for (int j = 0; j < 4; ++j) { VT_s[(kg * 16 + 2 * j) * 72 + t] = (bf16)(v0[j] & 0xffffu); VT_s[(kg * 16 + 2 * j + 1) * 72 + t] = (bf16)(v0[j] >> 16);
            VT_s[(kg * 16 + 8 + 2 * j) * 72 + t] = (bf16)(v1[j] & 0xffffu); VT_s[(kg * 16 + 8 + 2 * j + 1) * 72 + t] = (bf16)(v1[j] >> 16); }
        if (tid < 64) Dg[unit * 64 + tid] = __expf(BL[tid]);
    }
    __syncthreads();
    const int fr = lane & 15, fq = lane >> 4;
    {
#pragma unroll
        for (int i = 0; i < 2; ++i) { const int idx = w * 2 + i, mt = idx >> 2, nt = idx & 3;
            f32x4 acc = {0.f, 0.f, 0.f, 0.f};
            if (nt <= mt) acc = tile_mma(QE_s, 72, KD_s, 72, mt * 16, nt * 16, 64, lane);
#pragma unroll
            for (int j = 0; j < 4; ++j) { const int tt = mt * 16 + fq * 4 + j, s = nt * 16 + fr; A_s[tt * 72 + s] = (bf16)f2bf(s <= tt ? acc[j] : 0.f); } }
    }
    __syncthreads();
    {
        const int mt = w >> 1;
#pragma unroll
        for (int qd = 0; qd < 4; ++qd) { const int nt = (w & 1) * 4 + qd;
            const f32x4 a1 = tile_mma(A_s, 72, VT_s, 72, mt * 16, nt * 16, 64, lane);
            const f32x4 a2 = tile_mma(KET_s, 72, VT_s, 72, mt * 16, nt * 16, 64, lane);
#pragma unroll
            for (int j = 0; j < 4; ++j) { const size_t o = (size_t)unit * 8192 + (mt * 16 + fq * 4 + j) * 128 + nt * 16 + fr; OIg[o] = a1[j]; KVg[o] = a2[j]; } }
    }
    __syncthreads();
}

constexpr int LS_A = 0, LS_Q = 1024, LS_K = 2048, LS_V = 3072, LS_OP = 5120, LS_SS = 13312;
__device__ __forceinline__ void p2s_unit(unsigned char* lds, int unit, const bf16* P, const float* wup, const float* bgk, const float* gng, const float* state, float* out_state, bf16* MIX, int tid, int lane) {
    float* SA = (float*)(lds + LS_A); float* SQ = (float*)(lds + LS_Q); float* SK = (float*)(lds + LS_K); float* SV = (float*)(lds + LS_V); float* OP = (float*)(lds + LS_OP); float* SS = (float*)(lds + LS_SS);
    const int b = unit >> 2, h = unit & 3;
    const int rbase = NPROMPT + b * 4;
    if (tid < 256) { const int t = tid >> 6, k = tid & 63; const bf16* prow = P + (size_t)(rbase + t) * NINP;
        float x = bgk[h * 64 + k];
#pragma unroll
        for (int r = 0; r < 16; ++r) x += bf2f(prow[C_LR + r]) * wup[r * 256 + h * 64 + k];
        SA[t * 64 + k] = __expf(logsigmoid(x) * 0.0625f); SQ[t * 64 + k] = bf2f(prow[C_Q + h * 64 + k]) * 0.125f; SK[t * 64 + k] = bf2f(prow[C_K + h * 64 + k]); }
    { const int t = tid >> 7, dv = tid & 127; SV[t * 128 + dv] = bf2f(P[(size_t)(rbase + t) * NINP + C_V + h * 128 + dv]); }
    __syncthreads();
    {
        const int dv = tid & 127, kg = tid >> 7;
        const size_t sb = ((size_t)(b * 4 + h) * 64 + kg * 16) * 128 + dv;
        float S[16];
#pragma unroll
        for (int i = 0; i < 16; ++i) S[i] = state[sb + i * 128];
#pragma unroll
        for (int t = 0; t < 4; ++t) { const float vv = SV[t * 128 + dv]; float po = 0.f;
#pragma unroll
            for (int i = 0; i < 16; ++i) { const int dk = kg * 16 + i; S[i] = SA[t * 64 + dk] * S[i] + SK[t * 64 + dk] * vv; po += SQ[t * 64 + dk] * S[i]; }
            OP[(t * 4 + kg) * 128 + dv] = po; }
#pragma unroll
        for (int i = 0; i < 16; ++i) out_state[sb + i * 128] = S[i];
    }
    __syncthreads();
    const int t = tid >> 7, dv = tid & 127;
    const float o = (OP[(t * 4 + 0) * 128 + dv] + OP[(t * 4 + 1) * 128 + dv]) + (OP[(t * 4 + 2) * 128 + dv] + OP[(t * 4 + 3) * 128 + dv]);
    { const float ss = wave_sum(o * o); if (lane == 0) SS[t * 2 + ((tid >> 6) & 1)] = ss; }
    __syncthreads();
    { const float rs = 1.f / sqrtf((SS[t * 2] + SS[t * 2 + 1]) * (1.f / 128.f) + EPS);
      const float g = bf2f(P[(size_t)(rbase + t) * NINP + C_G + h * 128 + dv]);
      MIX[(size_t)(rbase + t) * 1024 + h * 128 + dv] = (bf16)f2bf(o * rs * gng[dv] * silu(g)); }
    __syncthreads();
}

__device__ __forceinline__ void load8bf(const bf16* p, float* o) { const u32x4 w = *(const u32x4*)p;
#pragma unroll
    for (int j = 0; j < 4; ++j) { o[2 * j] = blo(w[j]); o[2 * j + 1] = bhi(w[j]); } }
__device__ __forceinline__ void load8f(const float* p, float* o) { const f32x4 a = *(const f32x4*)p, b = *(const f32x4*)(p + 4);
#pragma unroll
    for (int j = 0; j < 4; ++j) { o[j] = a[j]; o[4 + j] = b[j]; } }
__device__ __forceinline__ void conv_item(int it, const bf16* P, const float* state_conv, const float* conv_w, bf16* MIX, float* out_conv_p, float* out_conv_s) {
    const int m = it >> 6, c0 = (it & 63) * 8;
    const bool samp = m >= NPROMPT;
    int b, t, L; if (!samp) { b = m >> 11; t = m & 2047; L = 2048; } else { b = (m - NPROMPT) >> 2; t = (m - NPROMPT) & 3; L = 4; }
    float acc[8], hcur[8];
#pragma unroll
    for (int j = 0; j < 8; ++j) { acc[j] = 0.f; hcur[j] = 0.f; }
#pragma unroll
    for (int jj = 0; jj < 3; ++jj) {
        const int idx = t + jj - 2; float hv[8];
        if (idx >= 0) { const bf16* prow = P + (size_t)(m + jj - 2) * NINP; float u[8], c[8]; load8bf(prow + C_U + c0, u); load8bf(prow + C_C + c0, c);
#pragma unroll
            for (int j = 0; j < 8; ++j) hv[j] = u[j] * c[j]; }
        else if (samp) load8f(state_conv + (size_t)(b * 2 + (t + jj)) * 512 + c0, hv);
        else {
#pragma unroll
            for (int j = 0; j < 8; ++j) hv[j] = 0.f; }
        float wv[8]; load8f(conv_w + jj * 512 + c0, wv);
#pragma unroll
        for (int j = 0; j < 8; ++j) { acc[j] += wv[j] * hv[j]; if (jj == 2) hcur[j] = hv[j]; }
    }
    const bf16* prow = P + (size_t)m * NINP; float bg[8], gc[8]; load8bf(prow + C_B + c0, bg); load8bf(prow + C_GC + c0, gc);
    u32x4 o;
#pragma unroll
    for (int j = 0; j < 4; ++j) o[j] = pk2(bg[2 * j] * acc[2 * j] * silu(gc[2 * j]), bg[2 * j + 1] * acc[2 * j + 1] * silu(gc[2 * j + 1]));
    *(u32x4*)(MIX + (size_t)m * 1024 + 512 + c0) = o;
    if (t >= L - 2) { float* dst = (samp ? out_conv_s : out_conv_p) + (size_t)(b * 2 + (t - (L - 2))) * 512 + c0;
        *(f32x4*)dst = (f32x4){hcur[0], hcur[1], hcur[2], hcur[3]}; *(f32x4*)(dst + 4) = (f32x4){hcur[4], hcur[5], hcur[6], hcur[7]}; }
}

constexpr int LC_QE = 0, LC_ST = 9216, LC_SS = 27648;
__device__ __forceinline__ void p2c_unit(unsigned char* lds, int unit, const bf16* P, const bf16* QEg, const bf16* SNg, const float* OIg, const float* gng, bf16* MIX, int tid, int w, int lane) {
    bf16* QE_s = (bf16*)(lds + LC_QE); bf16* ST_s = (bf16*)(lds + LC_ST); float* SS = (float*)(lds + LC_SS);
    const int bh = unit >> 5, n = unit & 31, b = bh >> 2, h = bh & 3;
    const int r0 = b * 2048 + n * 64;
    { const int t = tid >> 3, kg = tid & 7;
      *(u32x4*)(QE_s + t * 72 + kg * 8) = *(const u32x4*)(QEg + (size_t)unit * 4096 + t * 64 + kg * 8);
      const bf16* sp = SNg + (size_t)unit * 8192 + t * 128 + kg * 16;
      const u32x4 s0 = *(const u32x4*)sp, s1 = *(const u32x4*)(sp + 8);
#pragma unroll
      for (int j = 0; j < 4; ++j) { ST_s[(kg * 16 + 2 * j) * 72 + t] = (bf16)(s0[j] & 0xffffu); ST_s[(kg * 16 + 2 * j + 1) * 72 + t] = (bf16)(s0[j] >> 16);
          ST_s[(kg * 16 + 8 + 2 * j) * 72 + t] = (bf16)(s1[j] & 0xffffu); ST_s[(kg * 16 + 8 + 2 * j + 1) * 72 + t] = (bf16)(s1[j] >> 16); } }
    __syncthreads();
    const int fr = lane & 15, fq = lane >> 4, mt = w >> 1;
    f32x4 acc[4]; float ss[4] = {0.f, 0.f, 0.f, 0.f};
#pragma unroll
    for (int qd = 0; qd < 4; ++qd) { const int nt = (w & 1) * 4 + qd;
        acc[qd] = tile_mma(QE_s, 72, ST_s, 72, mt * 16, nt * 16, 64, lane);
#pragma unroll
        for (int j = 0; j < 4; ++j) { acc[qd][j] += OIg[(size_t)unit * 8192 + (mt * 16 + fq * 4 + j) * 128 + nt * 16 + fr]; ss[j] += acc[qd][j] * acc[qd][j]; } }
#pragma unroll
    for (int j = 0; j < 4; ++j) { float s = ss[j]; s += __shfl_xor(s, 1); s += __shfl_xor(s, 2); s += __shfl_xor(s, 4); s += __shfl_xor(s, 8); if (fr == 0) SS[(mt * 16 + fq * 4 + j) * 2 + (w & 1)] = s; }
    __syncthreads();
#pragma unroll
    for (int j = 0; j < 4; ++j) { const int tt = mt * 16 + fq * 4 + j; const float rs = 1.f / sqrtf((SS[tt * 2] + SS[tt * 2 + 1]) * (1.f / 128.f) + EPS);
        const bf16* prow = P + (size_t)(r0 + tt) * NINP + C_G + h * 128; bf16* mrow = MIX + (size_t)(r0 + tt) * 1024 + h * 128;
#pragma unroll
        for (int qd = 0; qd < 4; ++qd) { const int dv = ((w & 1) * 4 + qd) * 16 + fr; mrow[dv] = (bf16)f2bf(acc[qd][j] * rs * gng[dv] * silu(bf2f(prow[dv]))); } }
    __syncthreads();
}


__device__ __forceinline__ void scan_item(int e, const float* __restrict__ KVg, const float* __restrict__ Dg, bf16* __restrict__ SNg, float* __restrict__ outp) {
    const int bh = e >> 12, rem = e & 4095, dk = rem >> 6, dv = (rem & 63) * 2;
    f32x2 S = {0.f, 0.f};
#pragma unroll 1
    for (int n0 = 0; n0 < 32; n0 += 16) {
        f32x2 kv[16]; float d[16];
#pragma unroll
        for (int i = 0; i < 16; ++i) { const int unit = bh * 32 + n0 + i; kv[i] = *(const f32x2*)(KVg + (size_t)unit * 8192 + dk * 128 + dv); d[i] = Dg[unit * 64 + dk]; }
#pragma unroll
        for (int i = 0; i < 16; ++i) { const int unit = bh * 32 + n0 + i; *(unsigned*)(SNg + (size_t)unit * 8192 + dk * 128 + dv) = pk2(S.x, S.y); S = d[i] * S + kv[i]; }
    }
    *(f32x2*)(outp + (size_t)bh * 8192 + dk * 128 + dv) = S;
}

__global__ void __launch_bounds__(NTHR, 2) mk_fwd(Args a) {
    extern __shared__ __attribute__((aligned(16))) unsigned char lds[];
    cg::grid_group grid = cg::this_grid();
    if (a.ws == nullptr) grid.sync();
    if (threadIdx.x < 4) ((volatile LAS unsigned*)((LAS unsigned char*)lds + LDS_ST_OFF))[threadIdx.x] = 0u;
    __syncthreads();
    const XcdBarrier bar = xcd_barrier_post((unsigned*)a.ws, (volatile LAS unsigned*)((LAS unsigned char*)lds + LDS_ST_OFF));
    const int tid = threadIdx.x, lane = tid & 63, w = __builtin_amdgcn_readfirstlane(tid >> 6);
    const int G = gridDim.x, bid = blockIdx.x;
    const int gt = bid * NTHR + tid, NT = G * NTHR;
    const int gw = bid * NWAVES + w, NGW = G * NWAVES;
    const float* x_prompt = a.in[0]; const float* x_sample = a.in[1]; const float* state_gla = a.in[2]; const float* state_conv = a.in[3];
    const float* norm_gain = a.in[4]; const float* w_in = a.in[5]; const float* w_gk_up = a.in[6]; const float* b_gk = a.in[7];
    const float* gla_norm_gain = a.in[8]; const float* conv_w = a.in[9]; const float* w_out = a.in[10]; const float* final_gain = a.in[11];
    unsigned char* ws = a.ws; float* out = a.out;
    bf16* WTIN = (bf16*)(ws + WS_WTIN); bf16* WTOUT = (bf16*)(ws + WS_WTOUT); bf16* XN = (bf16*)(ws + WS_XN); bf16* P = (bf16*)(ws + WS_P); bf16* MIX = (bf16*)(ws + WS_MIX);
    bf16* QEg = (bf16*)(ws + WS_QE); float* OIg = (float*)(ws + WS_OI); float* KVg = (float*)(ws + WS_KV); bf16* SNg = (bf16*)(ws + WS_SN); float* Dg = (float*)(ws + WS_D); float* RSS = (float*)(ws + WS_RSS);

    for (int rep = 0; rep < REP0; ++rep) {
        float* scr = (float*)(lds + w * 8448);
        constexpr int I_IN = 16 * 120, I_OUT = 16 * 32;
        for (int it = gw; it < I_IN + I_OUT; it += NGW) {
            if (it < I_IN) p0_transpose_item(w_in, norm_gain, NIN, 120, WTIN, scr, it, lane);
            else p0_transpose_item(w_out, nullptr, 1024, 32, WTOUT, scr, it - I_IN, lane);
        }
        for (int m = gw; m < MROWS; m += NGW) rms_row_to_bf16(m < NPROMPT ? x_prompt + (size_t)m * DM : x_sample + (size_t)(m - NPROMPT) * DM, XN + (size_t)m * DM, lane);
    }
    GRID_BAR();
    for (int rep = 0; rep < REP1; ++rep) {
        pg8::Gemm g{XN, WTIN, MROWS, NINP, DM}; pg8::StaticOrder S; S.init(MROWS, NINP, G, bid);
        pg8::EpiBf16<0> E{P, NINP, nullptr, 0, 0, 1.f};
        pg8::gemm_phase<pg8::EpiBf16<0>, pg8::StaticOrder, PG8_ALIGN, PG8_SP2>((PG8_LAS unsigned char*)lds, g, S, E);
    }
    GRID_BAR();
    for (int rep = 0; rep < REP2A; ++rep) {
        for (int u = bid; u < NCHUNK_UNITS; u += G) p2a_unit(lds, u, P, w_gk_up, b_gk, QEg, OIg, KVg, Dg, tid, w, lane);
        for (int u = bid; u < NSAMP_UNITS; u += G) p2s_unit(lds, u, P, w_gk_up, b_gk, gla_norm_gain, state_gla, out + O_GLA_S, MIX, tid, lane);
        for (int it = gt; it < MROWS * 64; it += NT) conv_item(it, P, state_conv, conv_w, MIX, out + O_CONV_P, out + O_CONV_S);
    }
    GRID_BAR();
    for (int rep = 0; rep < REP2B; ++rep) {
        for (int e = gt; e < 32 * 4096; e += NT) scan_item(e, KVg, Dg, SNg, out + O_GLA_P);
    }
    GRID_BAR();
    for (int rep = 0; rep < REP2C; ++rep) {
        for (int u = bid; u < NCHUNK_UNITS; u += G) p2c_unit(lds, u, P, QEg, SNg, OIg, gla_norm_gain, MIX, tid, w, lane);
    }
    GRID_BAR();
    for (int rep = 0; rep < REP3; ++rep) {
        pg8::Gemm g{MIX, WTOUT, MROWS, DM, DM}; pg8::StaticOrder S; S.init(MROWS, DM, G, bid);
        pg8::EpiResF32 E{x_prompt, x_sample, out + O_Y, RSS};
        pg8::gemm_phase<pg8::EpiResF32, pg8::StaticOrder, PG8_ALIGN, PG8_SP2>((PG8_LAS unsigned char*)lds, g, S, E);
    }
    GRID_BAR();
    for (int rep = 0; rep < REPSYNC; ++rep) GRID_BAR();
    {
        for (int m = gw; m < MROWS; m += NGW) {
            float p = lane < 16 ? RSS[(size_t)m * 16 + lane] : 0.f;
            const float rs = 1.f / sqrtf(wave_sum(p) * (1.f / 1024.f) + EPS);
            f32x4* yr = (f32x4*)(out + O_Y + (size_t)m * DM) + lane; const f32x4* gr = (const f32x4*)final_gain + lane;
#pragma unroll
            for (int j = 0; j < 4; ++j) { const f32x4 v = yr[64 * j]; yr[64 * j] = v * rs * gr[64 * j]; }
        }
    }
}

extern "C" void kernel_launch(void* const* d_in, const int* in_sizes, int n_in, void* d_out, int out_size, void* d_ws, size_t ws_size, hipStream_t stream) {
    static int grid = 0;
    if (grid == 0) {
        if (n_in != 12 || ws_size < WS_END) { fprintf(stderr, "kernel_launch: unexpected n_in %d / ws %zu\n", n_in, ws_size); grid = -1; return; }
        int dev = 0, cus = 0, per_cu = 0;
        (void)hipGetDevice(&dev);
        (void)hipDeviceGetAttribute(&cus, hipDeviceAttributeMultiprocessorCount, dev);
        (void)hipFuncSetAttribute((const void*)mk_fwd, hipFuncAttributeMaxDynamicSharedMemorySize, LDS_BYTES);
        (void)hipOccupancyMaxActiveBlocksPerMultiprocessor(&per_cu, (const void*)mk_fwd, NTHR, LDS_BYTES);
        if (per_cu < 1) per_cu = 1;
        grid = cus * per_cu;
    }
    if (grid < 0) return;
    if (hipMemsetAsync(d_ws, 0, CTL_ZERO_BYTES, stream) != hipSuccess) { fprintf(stderr, "kernel_launch: memset failed\n"); return; }
    Args a{};
    for (int i = 0; i < 12; ++i) a.in[i] = (const float*)d_in[i];
    a.out = (float*)d_out; a.ws = (unsigned char*)d_ws;
    void* args[] = {&a};
    hipError_t e = hipLaunchCooperativeKernel((const void*)mk_fwd, dim3(grid), dim3(NTHR), args, LDS_BYTES, stream);
    if (e != hipSuccess) fprintf(stderr, "cooperative launch failed: %s (grid %d)\n", hipGetErrorString(e), grid);
}
```
